# Optimizing an MI355X kernel written in HIP

```python
import math
import jax, jax.numpy as jnp
from jax import lax
import numpy as np

D_MODEL = 1024
BATCH = 32
SEQ = 2048
DEPTH = 4

N_MIXERS = 3
D_FF = 4 * D_MODEL
RMS_EPS = 1e-6
NEG_INF = -1e30
NUM_BUCKETS = 32
REL_MAX_DISTANCE = 2048
DA_HEAD_DIM = 64
DA_HEADS = D_MODEL // (2 * DA_HEAD_DIM)
DA_Q_BLOCK = 128
LRU_WIDTH = D_MODEL
LRU_BLOCK_WIDTH = 256
LRU_BLOCKS = LRU_WIDTH // LRU_BLOCK_WIDTH
CONV_WIDTH = 4
LRU_C = 8.0
DIL_HEAD_DIM = 64
DIL_HEADS = D_MODEL // DIL_HEAD_DIM
DIL_PATTERNS = ((128, 1), (512, 4), (2048, 16))
DIL_GROUPS = len(DIL_PATTERNS)
BAND_BLOCK = 128
N_BIAS_COLS = 2 * DA_HEADS

kernel_name = 'hybrid_diffattn_rglru_dilated_adaln'


def rms_norm(x, gain):
    xf = x.astype(jnp.float32)
    y = xf * lax.rsqrt(jnp.mean(xf * xf, axis=-1, keepdims=True) + RMS_EPS)
    return (y * gain.astype(jnp.float32)).astype(x.dtype)


def modulate(h, shift, scale):
    return h * (1.0 + scale[:, None, :]) + shift[:, None, :]


def t5_bucket(dist):
    n = jnp.maximum(dist, 0)
    max_exact = NUM_BUCKETS // 2
    nf = jnp.maximum(n, max_exact).astype(jnp.float32)
    large = max_exact + (jnp.log(nf / max_exact) / math.log(REL_MAX_DISTANCE / max_exact)
                         * (NUM_BUCKETS - max_exact)).astype(jnp.int32)
    large = jnp.minimum(large, NUM_BUCKETS - 1)
    return jnp.where(n < max_exact, n, large)


def differential_attention(h, w_qkv, w_o, q_gain, k_gain, lam_q1, lam_k1, lam_q2, lam_k2,
                           sub_gain, rel_bias, lambda_init):
    B, S, _ = h.shape
    q, k, v = jnp.split(h @ w_qkv, 3, axis=-1)
    q = rms_norm(q.reshape(B, S, DA_HEADS, 2, DA_HEAD_DIM), q_gain) * (DA_HEAD_DIM ** -0.5)
    k = rms_norm(k.reshape(B, S, DA_HEADS, 2, DA_HEAD_DIM), k_gain)
    v = v.reshape(B, S, DA_HEADS, 2 * DA_HEAD_DIM)
    lam = (jnp.exp(jnp.sum(lam_q1.astype(jnp.float32) * lam_k1.astype(jnp.float32)))
           - jnp.exp(jnp.sum(lam_q2.astype(jnp.float32) * lam_k2.astype(jnp.float32)))
           + lambda_init)
    bq = min(DA_Q_BLOCK, S)
    outs = []
    for j in range(S // bq):
        q0, kv_len = j * bq, (j + 1) * bq
        s = jnp.einsum('bqhmd,bkhmd->bhmqk', q[:, q0:kv_len], k[:, :kv_len]).astype(jnp.float32)
        dist = jnp.arange(q0, kv_len)[:, None] - jnp.arange(kv_len)[None, :]
        bias = rel_bias[t5_bucket(dist)].reshape(bq, kv_len, DA_HEADS, 2).transpose(2, 3, 0, 1)
        s = jnp.where(dist >= 0, s + bias.astype(jnp.float32), NEG_INF)
        p = jax.nn.softmax(s, axis=-1)
        p = p[:, :, 0] - lam * p[:, :, 1]
        outs.append(jnp.einsum('bhqk,bkhe->bqhe', p.astype(v.dtype), v[:, :kv_len]))
    o = jnp.concatenate(outs, axis=1)
    o = rms_norm(o, sub_gain) * (1.0 - lambda_init)
    return o.reshape(B, S, D_MODEL) @ w_o


def rglru_block(h, w_in, conv_w, conv_b, w_x, b_x, w_a, b_a, a_param, w_out):
    B, S, _ = h.shape
    y, u = jnp.split(h @ w_in, 2, axis=-1)
    u_pad = jnp.pad(u, ((0, 0), (CONV_WIDTH - 1, 0), (0, 0)))
    conv = conv_b
    for tap in range(CONV_WIDTH):
        start = CONV_WIDTH - 1 - tap
        conv = conv + u_pad[:, start:start + S] * conv_w[tap]
    u = conv
    ub = u.reshape(B, S, LRU_BLOCKS, LRU_BLOCK_WIDTH)
    gate_x = jax.nn.sigmoid((jnp.einsum('bsni,nij->bsnj', ub, w_x).reshape(B, S, LRU_WIDTH) + b_x).astype(jnp.float32))
    gate_a = jax.nn.sigmoid((jnp.einsum('bsni,nij->bsnj', ub, w_a).reshape(B, S, LRU_WIDTH) + b_a).astype(jnp.float32))
    log_a = -LRU_C * gate_a * jax.nn.softplus(-a_param.astype(jnp.float32))
    a = jnp.exp(log_a)
    b = jnp.sqrt(-jnp.expm1(2.0 * log_a)) * (gate_x * u.astype(jnp.float32))

    def combine(left, right):
        a_l, b_l = left
        a_r, b_r = right
        return a_l * a_r, a_r * b_l + b_r

    _, hs = lax.associative_scan(combine, (a, b), axis=1)
    out = hs.astype(h.dtype) * jax.nn.gelu(y, approximate=True)
    return out @ w_out


def dilated_branch(q, k, v, dilation, sub_window, rel_bias):
    B, S, H, d = q.shape
    L = S // dilation
    bq = min(BAND_BLOCK, L)
    nb = -(-L // bq)
    pad = nb * bq - L

    def to_blocks(t):
        t = t.reshape(B, L, dilation, H, d)
        t = jnp.pad(t, ((0, 0), (0, pad), (0, 0), (0, 0), (0, 0)))
        t = t.reshape(B, nb, bq, dilation, H, d).transpose(1, 0, 3, 4, 2, 5)
        return t.reshape(nb, B * dilation, H, bq, d)

    def with_prev(t):
        prev = jnp.concatenate([jnp.zeros_like(t[:1]), t[:-1]], axis=0)
        return jnp.concatenate([prev, t], axis=3)

    qb = to_blocks(q)
    kb = with_prev(to_blocks(k))
    vb = with_prev(to_blocks(v))
    rel = jnp.arange(bq)[:, None] + bq - jnp.arange(2 * bq)[None, :]
    band = (rel >= 0) & (rel <= sub_window)
    bias = rel_bias[t5_bucket(rel * dilation)].transpose(2, 0, 1).astype(jnp.float32)
    in_current = jnp.arange(2 * bq) >= bq

    def block_step(args):
        j, qj, kj, vj = args
        s = jnp.einsum('nhqd,nhkd->nhqk', qj, kj).astype(jnp.float32) + bias
        mask = band & ((j > 0) | in_current)[None, :]
        s = jnp.where(mask, s, NEG_INF)
        m = jnp.max(s, axis=-1, keepdims=True)
        p = jnp.exp(s - m)
        den = jnp.sum(p, axis=-1)
        o = jnp.einsum('nhqk,nhkd->nhqd', (p / den[..., None]).astype(vj.dtype), vj).astype(jnp.float32)
        return o, m[..., 0] + jnp.log(den)

    o, lse = lax.map(block_step, (jnp.arange(nb), qb, kb, vb))
    o = o.reshape(nb, B, dilation, H, bq, d).transpose(1, 0, 4, 2, 3, 5)
    o = o.reshape(B, nb * bq, dilation, H, d)[:, :L].reshape(B, S, H, d)
    lse = lse.reshape(nb, B, dilation, H, bq).transpose(1, 0, 4, 2, 3)
    lse = lse.reshape(B, nb * bq, dilation, H)[:, :L].reshape(B, S, H)
    return o, lse


def dilated_attention(h, w_qkv, w_o, q_gain, k_gain, rel_bias):
    B, S, _ = h.shape
    o_acc, lse_acc = None, None
    for g, (window, dilation) in enumerate(DIL_PATTERNS):
        cols = w_qkv[:, g * 3 * D_MODEL:(g + 1) * 3 * D_MODEL]
        q, k, v = jnp.split(h @ cols, 3, axis=-1)
        q = rms_norm(q.reshape(B, S, DIL_HEADS, DIL_HEAD_DIM), q_gain) * (DIL_HEAD_DIM ** -0.5)
        k = rms_norm(k.reshape(B, S, DIL_HEADS, DIL_HEAD_DIM), k_gain)
        v = v.reshape(B, S, DIL_HEADS, DIL_HEAD_DIM)
        o_g, lse_g = dilated_branch(q, k, v, dilation, window // dilation, rel_bias)
        if o_acc is None:
            o_acc, lse_acc = o_g, lse_g
        else:
            lse_new = jnp.logaddexp(lse_acc, lse_g)
            o_acc = (o_acc * jnp.exp(lse_acc - lse_new)[..., None]
                     + o_g * jnp.exp(lse_g - lse_new)[..., None])
            lse_acc = lse_new
    return o_acc.astype(h.dtype).reshape(B, S, D_MODEL) @ w_o


def squared_relu_mlp(h, w1, w2):
    return jnp.square(jax.nn.relu(h @ w1)) @ w2


def setup_inputs(seed: int = 0) -> dict:
    key = jax.random.key(seed)
    ks = iter(jax.random.split(key, 40))
    n_a = len(range(0, DEPTH, N_MIXERS))
    n_b = len(range(1, DEPTH, N_MIXERS))
    n_c = len(range(2, DEPTH, N_MIXERS))
    D, W = D_MODEL, LRU_WIDTH

    def nrm(shape, scale):
        return jax.random.normal(next(ks), shape, jnp.float32) * scale

    def gain(shape):
        return 1.0 + nrm(shape, 0.05)

    inp = {}
    inp['x'] = nrm((BATCH, SEQ, D), 1.0)
    inp['c'] = nrm((BATCH, D), 1.0)
    inp['rel_bias'] = nrm((NUM_BUCKETS, N_BIAS_COLS), 0.5)
    inp['w_ada'] = nrm((DEPTH, D, 6 * D), 0.5 * D ** -0.5)
    inp['b_ada'] = nrm((DEPTH, 6 * D), 0.02)
    inp['norm_mix'] = gain((DEPTH, D))
    inp['norm_mlp'] = gain((DEPTH, D))
    inp['mlp_w1'] = nrm((DEPTH, D, D_FF), D ** -0.5)
    inp['mlp_w2'] = nrm((DEPTH, D_FF, D), D_FF ** -0.5)
    inp['da_w_qkv'] = nrm((n_a, D, 3 * D), D ** -0.5)
    inp['da_w_o'] = nrm((n_a, D, D), D ** -0.5)
    inp['da_q_gain'] = gain((n_a, DA_HEAD_DIM))
    inp['da_k_gain'] = gain((n_a, DA_HEAD_DIM))
    inp['da_lam_q1'] = nrm((n_a, DA_HEAD_DIM), 0.1)
    inp['da_lam_k1'] = nrm((n_a, DA_HEAD_DIM), 0.1)
    inp['da_lam_q2'] = nrm((n_a, DA_HEAD_DIM), 0.1)
    inp['da_lam_k2'] = nrm((n_a, DA_HEAD_DIM), 0.1)
    inp['da_sub_gain'] = gain((n_a, 2 * DA_HEAD_DIM))
    inp['lru_w_in'] = nrm((n_b, D, 2 * W), D ** -0.5)
    inp['lru_conv_w'] = nrm((n_b, CONV_WIDTH, W), CONV_WIDTH ** -0.5)
    inp['lru_conv_b'] = nrm((n_b, W), 0.02)
    inp['lru_w_x'] = nrm((n_b, LRU_BLOCKS, LRU_BLOCK_WIDTH, LRU_BLOCK_WIDTH), LRU_BLOCK_WIDTH ** -0.5)
    inp['lru_b_x'] = nrm((n_b, W), 0.02)
    inp['lru_w_a'] = nrm((n_b, LRU_BLOCKS, LRU_BLOCK_WIDTH, LRU_BLOCK_WIDTH), LRU_BLOCK_WIDTH ** -0.5)
    inp['lru_b_a'] = nrm((n_b, W), 0.02)
    a_c = jax.random.uniform(next(ks), (n_b, W), jnp.float32, minval=0.9, maxval=0.999)
    a0 = a_c ** (1.0 / LRU_C)
    inp['lru_a_param'] = jnp.log(a0) - jnp.log1p(-a0)
    inp['lru_w_out'] = nrm((n_b, W, D), W ** -0.5)
    inp['dil_w_qkv'] = nrm((n_c, D, DIL_GROUPS * 3 * D), D ** -0.5)
    inp['dil_w_o'] = nrm((n_c, D, D), D ** -0.5)
    inp['dil_q_gain'] = gain((n_c, DIL_HEAD_DIM))
    inp['dil_k_gain'] = gain((n_c, DIL_HEAD_DIM))
    return inp


def reference(x, c, rel_bias, w_ada, b_ada, norm_mix, norm_mlp, mlp_w1, mlp_w2,
              da_w_qkv, da_w_o, da_q_gain, da_k_gain, da_lam_q1, da_lam_k1, da_lam_q2, da_lam_k2, da_sub_gain,
              lru_w_in, lru_conv_w, lru_conv_b, lru_w_x, lru_b_x, lru_w_a, lru_b_a, lru_a_param, lru_w_out,
              dil_w_qkv, dil_w_o, dil_q_gain, dil_k_gain):
    mod = jnp.einsum('bd,ldk->lbk', jax.nn.silu(c), w_ada) + b_ada[:, None, :]
    for i in range(DEPTH):
        shift1, scale1, gate1, shift2, scale2, gate2 = jnp.split(mod[i], 6, axis=-1)
        h = modulate(rms_norm(x, norm_mix[i]), shift1, scale1)
        kind, slot = i % N_MIXERS, i // N_MIXERS
        if kind == 0:
            lambda_init = 0.8 - 0.6 * math.exp(-0.3 * i)
            y = differential_attention(h, da_w_qkv[slot], da_w_o[slot], da_q_gain[slot], da_k_gain[slot],
                                       da_lam_q1[slot], da_lam_k1[slot], da_lam_q2[slot], da_lam_k2[slot],
                                       da_sub_gain[slot], rel_bias, lambda_init)
        elif kind == 1:
            y = rglru_block(h, lru_w_in[slot], lru_conv_w[slot], lru_conv_b[slot], lru_w_x[slot], lru_b_x[slot],
                            lru_w_a[slot], lru_b_a[slot], lru_a_param[slot], lru_w_out[slot])
        else:
            y = dilated_attention(h, dil_w_qkv[slot], dil_w_o[slot], dil_q_gain[slot], dil_k_gain[slot], rel_bias)
        x = x + gate1[:, None, :] * y
        h = modulate(rms_norm(x, norm_mlp[i]), shift2, scale2)
        x = x + gate2[:, None, :] * squared_relu_mlp(h, mlp_w1[i], mlp_w2[i])
    return x
```

```cpp
#include <hip/hip_runtime.h>
#include <hip/hip_cooperative_groups.h>
#include <cstdio>
#include <cstdint>
namespace cg = cooperative_groups;

#define LAS __attribute__((address_space(3)))
#define GAS __attribute__((address_space(1)))
typedef unsigned short bf16;
typedef short bf16x8 __attribute__((ext_vector_type(8)));
typedef short s16x4 __attribute__((ext_vector_type(4)));
typedef float f32x4 __attribute__((ext_vector_type(4)));
typedef float f32x16 __attribute__((ext_vector_type(16)));
typedef unsigned u32x4 __attribute__((ext_vector_type(4)));
typedef unsigned u32x2 __attribute__((ext_vector_type(2)));

constexpr int NT_ = 512;
constexpr int TOK = 65536, DM = 1024, SEQ = 2048, NB = 32, DFF = 4096;
constexpr float LOG2E = 1.4426950408889634f;
constexpr float RMS_EPS = 1e-6f;
constexpr int LDS_XB_OFF = 139264 - 16;
constexpr int LDS_BYTES = 139264;

constexpr size_t MiB = 1u << 20;
constexpr size_t WS_SCAL = 0;
constexpr size_t WS_BAR = 128 * 1024;
constexpr size_t WS_SP = 64 * 1024;
constexpr size_t WS_MOD = 1 * MiB;
constexpr size_t WS_BIAS = 4 * MiB;
constexpr size_t WS_CS = 5 * MiB;
constexpr size_t WS_CH = 9 * MiB;
constexpr size_t WS_W = 16 * MiB;
constexpr size_t W_W1 = WS_W;
constexpr size_t W_W2 = W_W1 + 32 * MiB;
constexpr size_t W_DAQK = W_W2 + 32 * MiB;
constexpr size_t W_DAV = W_DAQK + 8 * MiB;
constexpr size_t W_DAO = W_DAV + 4 * MiB;
constexpr size_t W_LIN = W_DAO + 4 * MiB;
constexpr size_t W_LG = W_LIN + 4 * MiB;
constexpr size_t W_LOUT = W_LG + 1 * MiB;
constexpr size_t W_DLQK = W_LOUT + 2 * MiB;
constexpr size_t W_DLV = W_DLQK + 12 * MiB;
constexpr size_t W_DLO = W_DLV + 6 * MiB;
constexpr size_t W_END = W_DLO + 2 * MiB;
static_assert(W_END <= 128 * MiB, "weights fit");
constexpr size_t WS_H = 128 * MiB;
constexpr size_t WS_BIG = 256 * MiB;
constexpr size_t WS_QK = WS_BIG;
constexpr size_t WS_VT = WS_BIG + 256 * MiB;
constexpr size_t WS_AO = WS_BIG + 384 * MiB;
constexpr size_t WS_GY = WS_BIG;
constexpr size_t WS_U = WS_BIG + 128 * MiB;
constexpr size_t WS_UC = WS_BIG + 256 * MiB;
constexpr size_t WS_LA = WS_BIG + 384 * MiB;
constexpr size_t WS_BV = WS_H;
constexpr size_t WS_LSE = 768 * MiB;
constexpr size_t WS_XB = 776 * MiB;
constexpr size_t WS_END = 904 * MiB;

__device__ __forceinline__ int opaque_tid() { int t = threadIdx.x; asm volatile("" : "+v"(t)); return t; }
typedef float f32x2_t __attribute__((ext_vector_type(2))); typedef __bf16 bf16x2_t __attribute__((ext_vector_type(2)));
__device__ __forceinline__ unsigned cvt_pk_bf16(float lo, float hi) { f32x2_t v = {lo, hi}; bf16x2_t b = __builtin_convertvector(v, bf16x2_t); return __builtin_bit_cast(unsigned, b); }
__device__ __forceinline__ float shx(float v, int m, int lane) { return __int_as_float(__builtin_amdgcn_ds_bpermute((lane ^ m) << 2, __float_as_int(v))); }
__device__ __forceinline__ float wave_sum(float v, int lane) {
#pragma unroll
    for (int o = 1; o < 64; o <<= 1) v += shx(v, o, lane);
    return v;
}
__device__ __forceinline__ float max_x32(float v) { auto rr = __builtin_amdgcn_permlane32_swap(__float_as_uint(v), __float_as_uint(v), false, false); return fmaxf(__uint_as_float(rr[0]), __uint_as_float(rr[1])); }
__device__ __forceinline__ float sum_x32(float v) { auto rr = __builtin_amdgcn_permlane32_swap(__float_as_uint(v), __float_as_uint(v), false, false); return __uint_as_float(rr[0]) + __uint_as_float(rr[1]); }
__device__ __forceinline__ float bf2f(unsigned short h) { return __uint_as_float(((unsigned)h) << 16); }
__device__ __forceinline__ float bflo(unsigned w) { return __uint_as_float(w << 16); }
__device__ __forceinline__ float bfhi(unsigned w) { return __uint_as_float(w & 0xffff0000u); }
__device__ __forceinline__ float fast_exp2(float x) { return __builtin_amdgcn_exp2f(x); }
__device__ __forceinline__ float sigmoidf_(float x) { return 1.0f / (1.0f + __expf(-x)); }

namespace pg8 {
constexpr int BM = 256, BK = 64, HALF = 128, HTB = HALF * BK * 2, STAGE_BYTES = 8 * HTB, NXCD = 8, WGM = 8;
__host__ __device__ __forceinline__ int lds_byte(int r, int c) { const int st = (r >> 4) * 2 + (c >> 5), rr = r & 15, cc = c & 31, ob = rr * 64 + cc * 2; return st * 1024 + (ob ^ (((ob >> 9) & 1) << 5)); }
__host__ __device__ __forceinline__ void stage_rc(int b, int& R, int& C) { const int st = b / 1024, sb = b % 1024, swz = sb ^ (((sb >> 9) & 1) << 5); R = (st >> 1) * 16 + swz / 64; C = (st & 1) * 32 + (swz % 64) / 2; }
__host__ __device__ __forceinline__ int perm32(int rho) { const int n = rho >> 4, i = rho & 15; return 8 * (i >> 2) + 4 * n + (i & 3); }

struct Unit { int pm, pn; };
struct Gemm { const bf16* A; const bf16* Bt; int lda, ldb, K, nM, nN, dil, agrp; };

__device__ __forceinline__ const char* baseA(const Gemm& g, const Unit& u) {
    return (const char*)(g.A + (size_t)u.pm * 256 * g.lda + (g.agrp ? (u.pn >> 1) * 256 : 0));
}
__device__ __forceinline__ const char* baseB(const Gemm& g, const Unit& u) {
    if (g.dil == 1) return (const char*)(g.Bt + (size_t)u.pn * 256 * g.ldb);
    const int b = u.pn >> 3, q = u.pn & 7;
    int tok;
    if (g.dil == 4) tok = b * 2048 + (q & 1) * 256 * 4 + (q >> 1);
    else tok = b * 2048 + 2 * q;
    return (const char*)(g.Bt + (size_t)tok * 1024);
}

struct StaticOrder {
    int nM, nN, nwg, G, c;
    __device__ void init(int nM_, int nN_, int G_, int c_) { nM = nM_; nN = nN_; nwg = nM * nN; G = G_; c = c_; }
    __device__ bool next(int i, Unit& u) const {
        const long L = (long)i * G + c; if (L >= nwg) return false;
        int wgid = (int)L; { const int q = nwg / NXCD, r = nwg % NXCD, xcd = wgid % NXCD, off = wgid / NXCD; wgid = (xcd < r ? xcd * (q + 1) : r * (q + 1) + (xcd - r) * q) + off; }
        const int nig = WGM * nN, gid = wgid / nig, fm = gid * WGM, gsz = (nM - fm) < WGM ? (nM - fm) : WGM;
        u.pm = fm + ((wgid % nig) % gsz); u.pn = (wgid % nig) / gsz; return true;
    }
};

struct RowOrder {
    int nM, nN, nwg, G, c;
    __device__ void init(int nM_, int nN_, int G_, int c_) { nM = nM_; nN = nN_; nwg = nM * nN; G = G_; c = c_; }
    __device__ bool next(int i, Unit& u) const { const int r = i / nN, pn = i - r * nN, pm = c + r * G; if (pm >= nM) return false; u.pm = pm; u.pn = pn; return true; }
};


template <int ACT> struct EpiBf16 {
    static constexpr bool PERM = true;
    bf16* O; size_t ldc;
    __device__ __forceinline__ void operator()(const f32x4 (&acc)[2][2][4][2], const Unit& u, int wr, int wc, int fr, int fq) const {
        const int row0 = u.pm * BM + wr * 64 + fr; const int col0 = u.pn * BM + wc * 32 + 8 * fq;
#pragma unroll
        for (int ai = 0; ai < 2; ++ai)
#pragma unroll
            for (int m = 0; m < 4; ++m) { bf16* rowp = O + (size_t)(row0 + ai * HALF + m * 16) * ldc + col0;
#pragma unroll
                for (int bj = 0; bj < 2; ++bj) { f32x4 v0 = acc[ai][bj][m][0], v1 = acc[ai][bj][m][1];
                    if (ACT == 1) {
#pragma unroll
                        for (int e = 0; e < 4; ++e) { float a = fmaxf(v0[e], 0.f), b = fmaxf(v1[e], 0.f); v0[e] = a * a; v1[e] = b * b; } }
                    u32x4 w; w.x = cvt_pk_bf16(v0[0], v0[1]); w.y = cvt_pk_bf16(v0[2], v0[3]); w.z = cvt_pk_bf16(v1[0], v1[1]); w.w = cvt_pk_bf16(v1[2], v1[3]);
                    *(u32x4*)(rowp + bj * HALF) = w; } }
    }
};

struct EpiYU {
    static constexpr bool PERM = true;
    bf16* GY; bf16* U;
    static __device__ __forceinline__ float gelu_t(float y) {
        const float z2 = 1.5957691216057308f * (y + 0.044715f * y * y * y);
        return y * __builtin_amdgcn_rcpf(1.0f + __builtin_amdgcn_exp2f(-z2 * LOG2E));
    }
    __device__ __forceinline__ void operator()(const f32x4 (&acc)[2][2][4][2], const Unit& u, int wr, int wc, int fr, int fq) const {
        const bool isy = u.pn < 4; bf16* base = isy ? GY : U;
        const int row0 = u.pm * BM + wr * 64 + fr; const int col0 = (u.pn & 3) * BM + wc * 32 + 8 * fq;
#pragma unroll
        for (int ai = 0; ai < 2; ++ai)
#pragma unroll
            for (int m = 0; m < 4; ++m) { bf16* rowp = base + (size_t)(row0 + ai * HALF + m * 16) * 1024 + col0;
#pragma unroll
                for (int bj = 0; bj < 2; ++bj) { f32x4 v0 = acc[ai][bj][m][0], v1 = acc[ai][bj][m][1];
                    asm volatile("" : "+v"(v0), "+v"(v1));
                    if (isy) {
#pragma unroll
                        for (int e = 0; e < 4; ++e) { v0[e] = gelu_t(v0[e]); v1[e] = gelu_t(v1[e]); } }
                    u32x4 w; w.x = cvt_pk_bf16(v0[0], v0[1]); w.y = cvt_pk_bf16(v0[2], v0[3]); w.z = cvt_pk_bf16(v1[0], v1[1]); w.w = cvt_pk_bf16(v1[2], v1[3]);
                    *(u32x4*)(rowp + bj * HALF) = w; }
                asm volatile("" ::: "memory"); }
    }
};

struct EpiQK {
    static constexpr bool PERM = true;
    bf16* O; const float* qg; const float* kg;
    __device__ __forceinline__ void operator()(const f32x4 (&acc)[2][2][4][2], const Unit& u, int wr, int wc, int fr, int fq) const {
        const bool isq = u.pn < 4; const float* gp = isq ? qg : kg; const float mult = isq ? 0.125f * LOG2E : 1.0f;
        const int row0 = u.pm * BM + wr * 64 + fr; const int col0 = u.pn * BM + wc * 64 + 8 * fq;
        f32x4 gv[2][2];
#pragma unroll
        for (int bj = 0; bj < 2; ++bj)
#pragma unroll
            for (int n = 0; n < 2; ++n) gv[bj][n] = *(const f32x4*)(gp + 32 * bj + 8 * fq + 4 * n);
#pragma unroll
        for (int ai = 0; ai < 2; ++ai)
#pragma unroll
            for (int m = 0; m < 4; ++m) {
                float ss = 0.f;
                f32x4 xv[2][2];
#pragma unroll
                for (int bj = 0; bj < 2; ++bj)
#pragma unroll
                    for (int n = 0; n < 2; ++n) xv[bj][n] = acc[ai][bj][m][n];
                asm volatile("" : "+v"(xv[0][0]), "+v"(xv[0][1]), "+v"(xv[1][0]), "+v"(xv[1][1]));
#pragma unroll
                for (int bj = 0; bj < 2; ++bj)
#pragma unroll
                    for (int n = 0; n < 2; ++n) { const f32x4 x = xv[bj][n]; ss += (x[0] * x[0] + x[1] * x[1]) + (x[2] * x[2] + x[3] * x[3]); }
                { const int ln = fq * 16 + fr; ss += shx(ss, 16, ln); ss += shx(ss, 32, ln); }
                const float rs = rsqrtf(ss * (1.0f / 64.0f) + RMS_EPS) * mult;
                bf16* rowp = O + (size_t)(row0 + ai * HALF + m * 16) * 2048 + col0;
#pragma unroll
                for (int bj = 0; bj < 2; ++bj) { const f32x4 v0 = xv[bj][0] * gv[bj][0] * rs, v1 = xv[bj][1] * gv[bj][1] * rs;
                    u32x4 w; w.x = cvt_pk_bf16(v0[0], v0[1]); w.y = cvt_pk_bf16(v0[2], v0[3]); w.z = cvt_pk_bf16(v1[0], v1[1]); w.w = cvt_pk_bf16(v1[2], v1[3]);
                    *(u32x4*)(rowp + bj * 32) = w; }
                asm volatile("" ::: "memory"); }
    }
};

struct EpiGates {
    static constexpr bool PERM = true;
    bf16* GX; bf16* GA;
    __device__ __forceinline__ void operator()(const f32x4 (&acc)[2][2][4][2], const Unit& u, int wr, int wc, int fr, int fq) const {
        const int ch0 = (u.pn >> 1) * 256 + (u.pn & 1) * 128 + wc * 32 + 8 * fq;
        const int row0 = u.pm * BM + wr * 64 + fr;
#pragma unroll
        for (int ai = 0; ai < 2; ++ai)
#pragma unroll
            for (int m = 0; m < 4; ++m) {
                const size_t off = (size_t)(row0 + ai * HALF + m * 16) * 1024 + ch0;
                const f32x4 x0 = acc[ai][0][m][0], x1 = acc[ai][0][m][1], a0 = acc[ai][1][m][0], a1 = acc[ai][1][m][1];
                u32x4 w1, w2;
                w1.x = cvt_pk_bf16(x0[0], x0[1]); w1.y = cvt_pk_bf16(x0[2], x0[3]); w1.z = cvt_pk_bf16(x1[0], x1[1]); w1.w = cvt_pk_bf16(x1[2], x1[3]);
                w2.x = cvt_pk_bf16(a0[0], a0[1]); w2.y = cvt_pk_bf16(a0[2], a0[3]); w2.z = cvt_pk_bf16(a1[0], a1[1]); w2.w = cvt_pk_bf16(a1[2], a1[3]);
                *(u32x4*)(GX + off) = w1; *(u32x4*)(GA + off) = w2;
            }
    }
};

struct EpiResid {
    static constexpr bool PERM = true;
    const float* xin_f32; const bf16* xin_b; float* xout_f32; bf16* xout_b; const float* gate;
    __device__ __forceinline__ void operator()(const f32x4 (&acc)[2][2][4][2], const Unit& u, int wr, int wc, int fr, int fq) const {
        const int col0 = u.pn * BM + wc * 32 + 8 * fq; const int row0 = u.pm * BM + wr * 64 + fr;
        const float* gp = gate + (size_t)(u.pm >> 3) * 6144 + col0;
        f32x4 gv[2][2];
#pragma unroll
        for (int bj = 0; bj < 2; ++bj)
#pragma unroll
            for (int n = 0; n < 2; ++n) gv[bj][n] = *(const f32x4*)(gp + bj * HALF + n * 4);
#pragma unroll
        for (int ai = 0; ai < 2; ++ai)
#pragma unroll
            for (int m = 0; m < 4; ++m) { const size_t off = (size_t)(row0 + ai * HALF + m * 16) * 1024 + col0;
#pragma unroll
                for (int bj = 0; bj < 2; ++bj) {
                    f32x4 x0, x1;
                    if (xin_f32) { x0 = *(const f32x4*)(xin_f32 + off + bj * HALF); x1 = *(const f32x4*)(xin_f32 + off + bj * HALF + 4); }
                    else { const u32x4 w = *(const u32x4*)(xin_b + off + bj * HALF); x0 = (f32x4){bflo(w.x), bfhi(w.x), bflo(w.y), bfhi(w.y)}; x1 = (f32x4){bflo(w.z), bfhi(w.z), bflo(w.w), bfhi(w.w)}; }
                    x0 = x0 + gv[bj][0] * acc[ai][bj][m][0]; x1 = x1 + gv[bj][1] * acc[ai][bj][m][1];
                    if (xout_f32) { *(f32x4*)(xout_f32 + off + bj * HALF) = x0; *(f32x4*)(xout_f32 + off + bj * HALF + 4) = x1; }
                    else { u32x4 w; w.x = cvt_pk_bf16(x0[0], x0[1]); w.y = cvt_pk_bf16(x0[2], x0[3]); w.z = cvt_pk_bf16(x1[0], x1[1]); w.w = cvt_pk_bf16(x1[2], x1[3]); *(u32x4*)(xout_b + off + bj * HALF) = w; }
                } }
    }
};

template <class Epi, class Sched>
__device__ __forceinline__ void gemm_phase(LAS unsigned char* lds, Gemm g, Sched S, const Epi& E) {
    asm volatile("" : "+s"(g.A), "+s"(g.Bt), "+s"(S.c), "+s"(S.G));
    const int tid = opaque_tid(), wid = __builtin_amdgcn_readfirstlane(tid >> 6), lane = tid & 63, wr = wid >> 2, wc = wid & 3, fr = lane & 15, fq = lane >> 4;
    const int K = g.K, nt = K / BK;
    unsigned voffA[2], voffB[2];
#pragma unroll
    for (int i = 0; i < 2; ++i) { int R, C; stage_rc(tid * 16 + i * 8192, R, C); const int Rb = Epi::PERM ? ((R & ~31) + perm32(R & 31)) : R;
        voffA[i] = (unsigned)(R * g.lda + C) * 2u; voffB[i] = (unsigned)(Rb * g.ldb + C) * 2u; }
    const size_t kstep = (size_t)(BK * 2);
    const size_t hstepA = (size_t)HALF * g.lda * 2;
    const size_t hstepB = (g.dil == 16) ? (size_t)2048 : (size_t)HALF * g.ldb * 2;
    const unsigned ldsw = (unsigned)wid * 1024u;
    const int aoff = lds_byte(wr * 64 + fr, fq * 8), boff = lds_byte(wc * 32 + fr, fq * 8);
#define PG8_SA(b, h) (((b) * 2 + (h)) * HTB)
#define PG8_SB(b, h) ((4 + (b) * 2 + (h)) * HTB)
#define PG8_STAGE(bufoff, gbase, voff) do { const char* _gb = (const char*)(gbase); asm("" : "+s"(_gb)); _Pragma("unroll") for (int _i = 0; _i < 2; ++_i) \
        __builtin_amdgcn_global_load_lds((const unsigned*)(_gb + (voff)[_i]), (LAS unsigned*)(lds + (bufoff) + ldsw + _i * 8192), 16, 0, 0); } while (0)
#define PG8_LDA(dst, b, h) do { _Pragma("unroll") for (int m = 0; m < 4; ++m) _Pragma("unroll") for (int k = 0; k < 2; ++k) dst[m][k] = *(const LAS bf16x8*)(lds + PG8_SA(b, h) + aoff + m * 2048 + k * 1024); } while (0)
#define PG8_LDB(dst, b, h) do { _Pragma("unroll") for (int n = 0; n < 2; ++n) _Pragma("unroll") for (int k = 0; k < 2; ++k) dst[n][k] = *(const LAS bf16x8*)(lds + PG8_SB(b, h) + boff + n * 2048 + k * 1024); } while (0)
#define PG8_MMA(ai, bj, At, Bt) do { __builtin_amdgcn_s_setprio(1); _Pragma("unroll") for (int m = 0; m < 4; ++m) _Pragma("unroll") for (int n = 0; n < 2; ++n) _Pragma("unroll") for (int k = 0; k < 2; ++k) \
        acc[ai][bj][m][n] = __builtin_amdgcn_mfma_f32_16x16x32_bf16(Bt[n][k], At[m][k], acc[ai][bj][m][n], 0, 0, 0); __builtin_amdgcn_s_setprio(0); } while (0)
#define PG8_WAIT_V(n) asm volatile("s_waitcnt vmcnt(" #n ")" ::: "memory")
#define PG8_WAIT_L(n) asm volatile("s_waitcnt lgkmcnt(" #n ")" ::: "memory")
#define PG8_BAR __builtin_amdgcn_s_barrier()
#define PG8_SCHED __builtin_amdgcn_sched_barrier(0)
    Unit cur, nxt; int ui = 0;
    if (!S.next(0, cur)) return;
    f32x4 acc[2][2][4][2];
#pragma unroll
    for (int a = 0; a < 2; ++a)
#pragma unroll
        for (int b = 0; b < 2; ++b)
#pragma unroll
            for (int m = 0; m < 4; ++m)
#pragma unroll
                for (int n = 0; n < 2; ++n) acc[a][b][m][n] = (f32x4){0.f, 0.f, 0.f, 0.f};
    bf16x8 At[4][2], B0[2][2], B1[2][2];
    const char* cA = baseA(g, cur); const char* cB = baseB(g, cur);
    PG8_STAGE(PG8_SB(0, 0), cB, voffB); PG8_STAGE(PG8_SB(0, 1), cB + hstepB, voffB); PG8_STAGE(PG8_SA(0, 0), cA, voffA); PG8_STAGE(PG8_SA(0, 1), cA + hstepA, voffA);
    if (wr == 1) PG8_BAR;
    PG8_WAIT_V(2); PG8_BAR;
    PG8_STAGE(PG8_SB(1, 0), cB + kstep, voffB); PG8_STAGE(PG8_SA(1, 0), cA + kstep, voffA); PG8_STAGE(PG8_SB(1, 1), cB + hstepB + kstep, voffB);
    PG8_WAIT_V(6); PG8_BAR;
    for (;;) {
        const bool has_next = S.next(ui + 1, nxt);
        const char* nA = has_next ? baseA(g, nxt) : cA; const char* nB = has_next ? baseB(g, nxt) : cB;
        for (int t = 0; t < nt; t += 2) {
            const bool last = (t == nt - 2);
            const char* a1 = cA + (size_t)(t + 1) * kstep;
            const char* a2 = last ? nA : cA + (size_t)(t + 2) * kstep; const char* b2 = last ? nB : cB + (size_t)(t + 2) * kstep;
            const char* a3 = a2 + kstep; const char* b3 = b2 + kstep;
            PG8_LDB(B0, 0, 0); PG8_LDB(B1, 0, 1); PG8_SCHED; PG8_LDA(At, 0, 0); PG8_STAGE(PG8_SA(1, 1), a1 + hstepA, voffA);
            PG8_WAIT_V(8); PG8_WAIT_L(0); PG8_BAR; PG8_MMA(0, 0, At, B0); PG8_MMA(0, 1, At, B1); PG8_BAR; PG8_SCHED;
            PG8_LDA(At, 0, 1); PG8_STAGE(PG8_SB(0, 0), b2, voffB); PG8_STAGE(PG8_SB(0, 1), b2 + hstepB, voffB); PG8_STAGE(PG8_SA(0, 0), a2, voffA);
            PG8_WAIT_V(8); PG8_WAIT_L(0); PG8_BAR; PG8_MMA(1, 0, At, B0); PG8_MMA(1, 1, At, B1); PG8_BAR; PG8_SCHED;
            PG8_LDB(B0, 1, 0); PG8_LDB(B1, 1, 1); PG8_SCHED; PG8_LDA(At, 1, 0); PG8_STAGE(PG8_SA(0, 1), a2 + hstepA, voffA);
            PG8_WAIT_V(8); PG8_WAIT_L(0); PG8_BAR; PG8_MMA(0, 0, At, B0); PG8_MMA(0, 1, At, B1); PG8_BAR; PG8_SCHED;
            PG8_LDA(At, 1, 1); PG8_STAGE(PG8_SB(1, 0), b3, voffB); PG8_STAGE(PG8_SB(1, 1), b3 + hstepB, voffB); PG8_STAGE(PG8_SA(1, 0), a3, voffA);
            PG8_WAIT_V(8); PG8_WAIT_L(0); PG8_BAR; PG8_MMA(1, 0, At, B0); PG8_MMA(1, 1, At, B1); PG8_BAR; PG8_SCHED;
        }
        if (wr == 0) PG8_BAR;
        { const int te = opaque_tid(), we = __builtin_amdgcn_readfirstlane(te >> 6), le = te & 63;
          E(acc, cur, we >> 2, we & 3, le & 15, le >> 4); }
        if (!has_next) break;
#pragma unroll
        for (int a = 0; a < 2; ++a)
#pragma unroll
            for (int b = 0; b < 2; ++b)
#pragma unroll
                for (int m = 0; m < 4; ++m)
#pragma unroll
                    for (int n = 0; n < 2; ++n) acc[a][b][m][n] = (f32x4){0.f, 0.f, 0.f, 0.f};
        cur = nxt; cA = nA; cB = nB; ++ui;
        if (wr == 1) PG8_BAR;
    }
    PG8_WAIT_V(0);
    PG8_BAR;
#undef PG8_SA
#undef PG8_SB
#undef PG8_STAGE
#undef PG8_LDA
#undef PG8_LDB
#undef PG8_MMA
#undef PG8_WAIT_V
#undef PG8_WAIT_L
#undef PG8_BAR
#undef PG8_SCHED
}
}

constexpr int AT_KROW = 272, AT_VROW = 136, AT_KBYTES = 64 * AT_KROW, AT_VBYTES = 128 * AT_VROW, AT_BUF = AT_KBYTES + AT_VBYTES;
constexpr int AT_BIAS_OFF = 2 * AT_BUF;
template <int MODE>
__device__ __forceinline__ void attn_unit(LAS unsigned char* lds, const bf16* QK, const bf16* Vt, const float* biasT,
                                          int b, int hp, int c, int dil, int jblk, bf16* AO, float* LSE, int gidx,
                                          float lam, const float* subgain, float one_m_li, bool load_bias) {
    constexpr int NDV = (MODE == 0) ? 4 : 2;
    const int tid = opaque_tid(), lane = tid & 63, wid = __builtin_amdgcn_readfirstlane(tid >> 6);
    const int mp = wid >> 2, wq = wid & 3, r32 = lane & 31, hi = lane >> 5;
    const int L = SEQ / dil;
    const size_t tok0 = (size_t)b * SEQ + c;
    const size_t vcol0 = (size_t)b * SEQ + (size_t)c * L;
    LAS float* biasL = (LAS float*)(lds + AT_BIAS_OFF);
    if (load_bias) {
        const int nb = (MODE == 0) ? 2048 : 129;
        for (int i = tid; i < 2 * nb; i += NT_) { const int mm = i / nb, ii = i - mm * nb; biasL[mm * 2048 + ii] = biasT[(size_t)(2 * hp + mm) * 2048 + min(ii * dil, 2047)]; }
    }
    const int q_lo = 128 * jblk + 32 * wq;
    const int qi = q_lo + r32;
    const size_t qtok = tok0 + (size_t)qi * dil;
    bf16x8 qf[4];
#pragma unroll
    for (int ds = 0; ds < 4; ++ds) qf[ds] = *(const bf16x8*)(QK + qtok * 2048 + (2 * hp + mp) * 64 + 16 * ds + 8 * hi);
    const int kt_hi = 2 * jblk + 1;
    const int kt_lo = (MODE == 0) ? 0 : ((jblk > 0) ? 2 * jblk - 2 : 0);
    const int kp_row0 = tid >> 4, kp_c = tid & 15;
    const int vp_row0 = tid >> 3, vp_c = tid & 7;
    const bf16* ksrc = QK + 1024 + 2 * hp * 64 + kp_c * 8;
    const bf16* vsrc = Vt + (size_t)(2 * hp * 64 + vp_row0) * TOK + vcol0 + vp_c * 8;
    u32x4 kr0, kr1, vr0, vr1;
    {
        const int kv0 = 64 * kt_lo;
        kr0 = *(const u32x4*)(ksrc + (tok0 + (size_t)(kv0 + kp_row0) * dil) * 2048);
        kr1 = *(const u32x4*)(ksrc + (tok0 + (size_t)(kv0 + kp_row0 + 32) * dil) * 2048);
        vr0 = *(const u32x4*)(vsrc + kv0);
        vr1 = *(const u32x4*)(vsrc + (size_t)64 * TOK + kv0);
        LAS unsigned char* kb = lds; LAS unsigned char* vb = lds + AT_KBYTES;
        *(LAS u32x4*)(kb + kp_row0 * AT_KROW + kp_c * 16) = kr0; *(LAS u32x4*)(kb + (kp_row0 + 32) * AT_KROW + kp_c * 16) = kr1;
        { LAS unsigned char* p0 = vb + vp_row0 * AT_VROW + vp_c * 16; LAS unsigned char* p1 = vb + (vp_row0 + 64) * AT_VROW + vp_c * 16;
          *(LAS u32x2*)p0 = (u32x2){vr0.x, vr0.y}; *(LAS u32x2*)(p0 + 8) = (u32x2){vr0.z, vr0.w}; *(LAS u32x2*)p1 = (u32x2){vr1.x, vr1.y}; *(LAS u32x2*)(p1 + 8) = (u32x2){vr1.z, vr1.w}; }
    }
    f32x16 acc[NDV];
#pragma unroll
    for (int i = 0; i < NDV; ++i)
#pragma unroll
        for (int r = 0; r < 16; ++r) acc[i][r] = 0.f;
    float mrun = -1e30f, lsum = 0.f;
    float la_pre = 0.f; u32x2 pw_pre[NDV][4];
    if (MODE == 1 && gidx > 0) {
        la_pre = LSE[qtok * 16 + 2 * hp + mp];
#pragma unroll
        for (int dvb = 0; dvb < NDV; ++dvb)
#pragma unroll
            for (int g4 = 0; g4 < 4; ++g4) pw_pre[dvb][g4] = *(const u32x2*)(AO + qtok * 1024 + (2 * hp + mp) * 64 + 32 * dvb + 8 * g4 + 4 * hi);
    }
    const int dvoff = (MODE == 0) ? 0 : 64 * mp;
    for (int kt = kt_lo; kt <= kt_hi; ++kt) {
        const int bufsel = (kt - kt_lo) & 1;
        __syncthreads();
        const bool more = kt < kt_hi;
        if (more) {
            const int kv1 = 64 * (kt + 1);
            kr0 = *(const GAS u32x4*)(ksrc + (tok0 + (size_t)(kv1 + kp_row0) * dil) * 2048);
            kr1 = *(const GAS u32x4*)(ksrc + (tok0 + (size_t)(kv1 + kp_row0 + 32) * dil) * 2048);
            vr0 = *(const GAS u32x4*)(vsrc + kv1);
            vr1 = *(const GAS u32x4*)(vsrc + (size_t)64 * TOK + kv1);
            asm volatile("" ::: "memory");
        }
        const int kv0 = 64 * kt;
        bool skip = kv0 > q_lo + 31;
        if (MODE == 1) skip = skip || (kv0 + 63 < q_lo - 128);
        if (!skip) {
            const LAS unsigned char* kb = lds + bufsel * AT_BUF; const LAS unsigned char* vb = kb + AT_KBYTES;
            f32x16 s0, s1;
#pragma unroll
            for (int r = 0; r < 16; ++r) { s0[r] = 0.f; s1[r] = 0.f; }
            {
                bf16x8 ka[4], kc[4];
#pragma unroll
                for (int ds = 0; ds < 4; ++ds) {
                    ka[ds] = *(const LAS bf16x8*)(kb + r32 * AT_KROW + mp * 128 + (16 * ds + 8 * hi) * 2);
                    kc[ds] = *(const LAS bf16x8*)(kb + (32 + r32) * AT_KROW + mp * 128 + (16 * ds + 8 * hi) * 2);
                }
                __builtin_amdgcn_sched_barrier(0);
#pragma unroll
                for (int ds = 0; ds < 4; ++ds) {
                    s0 = __builtin_amdgcn_mfma_f32_32x32x16_bf16(ka[ds], qf[ds], s0, 0, 0, 0);
                    s1 = __builtin_amdgcn_mfma_f32_32x32x16_bf16(kc[ds], qf[ds], s1, 0, 0, 0);
                }
            }
            const int relbase = qi - kv0 - 4 * hi;
            constexpr int cmax = (MODE == 0) ? 2047 : 128;
            float mx = -1e30f;
            bool interior = (kv0 + 63 <= q_lo);
            if (MODE == 1) interior = interior && (q_lo + 31 - kv0 <= 128);
            if (interior) {
                const LAS float* p = biasL + mp * 2048 + (relbase - 59);
#pragma unroll
                for (int r = 0; r < 16; ++r) {
                    const int o = 59 - ((r & 3) + 8 * (r >> 2));
                    s0[r] += p[o]; s1[r] += p[o - 32];
                    mx = fmaxf(mx, fmaxf(s0[r], s1[r]));
                }
            } else {
                const volatile LAS float* bl = (const volatile LAS float*)(biasL + mp * 2048);
                float bb0[16], bb1[16];
#pragma unroll
                for (int r = 0; r < 16; ++r) {
                    const int rel0 = relbase - ((r & 3) + 8 * (r >> 2));
                    bb0[r] = bl[min(max(rel0, 0), cmax)]; bb1[r] = bl[min(max(rel0 - 32, 0), cmax)];
                }
#pragma unroll
                for (int r = 0; r < 16; ++r) {
                    const int rel0 = relbase - ((r & 3) + 8 * (r >> 2)), rel1 = rel0 - 32;
                    bool ok0 = rel0 >= 0, ok1 = rel1 >= 0;
                    if (MODE == 1) { ok0 = ok0 && (rel0 <= 128); ok1 = ok1 && (rel1 <= 128); }
                    const float t0 = s0[r] + bb0[r], t1 = s1[r] + bb1[r];
                    s0[r] = ok0 ? t0 : -1e30f; s1[r] = ok1 ? t1 : -1e30f;
                    mx = fmaxf(mx, fmaxf(s0[r], s1[r]));
                }
            }
            mx = max_x32(mx);
            const float mnew = fmaxf(mrun, mx);
            const float alpha = fast_exp2(mrun - mnew);
            mrun = mnew;
            float ps = 0.f;
#pragma unroll
            for (int r = 0; r < 16; ++r) { s0[r] = fast_exp2(s0[r] - mnew); s1[r] = fast_exp2(s1[r] - mnew); ps += s0[r] + s1[r]; }
            lsum = lsum * alpha + ps;
#pragma unroll
            for (int i = 0; i < NDV; ++i)
#pragma unroll
                for (int r = 0; r < 16; ++r) acc[i][r] *= alpha;
            bf16x8 pf[2][2];
#pragma unroll
            for (int t = 0; t < 2; ++t) {
                u32x4 w0, w1;
                w0.x = cvt_pk_bf16(s0[8 * t + 0], s0[8 * t + 1]); w0.y = cvt_pk_bf16(s0[8 * t + 2], s0[8 * t + 3]); w0.z = cvt_pk_bf16(s0[8 * t + 4], s0[8 * t + 5]); w0.w = cvt_pk_bf16(s0[8 * t + 6], s0[8 * t + 7]);
                w1.x = cvt_pk_bf16(s1[8 * t + 0], s1[8 * t + 1]); w1.y = cvt_pk_bf16(s1[8 * t + 2], s1[8 * t + 3]); w1.z = cvt_pk_bf16(s1[8 * t + 4], s1[8 * t + 5]); w1.w = cvt_pk_bf16(s1[8 * t + 6], s1[8 * t + 7]);
                pf[0][t] = __builtin_bit_cast(bf16x8, w0); pf[1][t] = __builtin_bit_cast(bf16x8, w1);
            }
#define AT_LOADV(dst, dvb_) do { const LAS unsigned char* vrow_ = vb + (dvoff + 32 * (dvb_) + r32) * AT_VROW + 8 * hi; \
                _Pragma("unroll") for (int i_ = 0; i_ < 4; ++i_) { const s16x4 lo4_ = *(const LAS s16x4*)(vrow_ + (16 * i_) * 2), hi4_ = *(const LAS s16x4*)(vrow_ + (16 * i_ + 8) * 2); \
                    dst[i_] = (bf16x8){lo4_[0], lo4_[1], lo4_[2], lo4_[3], hi4_[0], hi4_[1], hi4_[2], hi4_[3]}; } } while (0)
            {
                bf16x8 vcur[4], vnxt[4];
                AT_LOADV(vcur, 0);
#pragma unroll
                for (int dvb = 0; dvb < NDV; ++dvb) {
                    if (dvb + 1 < NDV) AT_LOADV(vnxt, dvb + 1);
                    __builtin_amdgcn_sched_barrier(0);
#pragma unroll
                    for (int i = 0; i < 4; ++i) acc[dvb] = __builtin_amdgcn_mfma_f32_32x32x16_bf16(vcur[i], pf[i >> 1][i & 1], acc[dvb], 0, 0, 0);
                    __builtin_amdgcn_sched_barrier(0);
#pragma unroll
                    for (int i = 0; i < 4; ++i) vcur[i] = vnxt[i];
                }
            }
#undef AT_LOADV
        }
        if (more) {
            LAS unsigned char* kb = lds + (bufsel ^ 1) * AT_BUF; LAS unsigned char* vb = kb + AT_KBYTES;
            *(LAS u32x4*)(kb + kp_row0 * AT_KROW + kp_c * 16) = kr0; *(LAS u32x4*)(kb + (kp_row0 + 32) * AT_KROW + kp_c * 16) = kr1;
            { LAS unsigned char* p0 = vb + vp_row0 * AT_VROW + vp_c * 16; LAS unsigned char* p1 = vb + (vp_row0 + 64) * AT_VROW + vp_c * 16;
          *(LAS u32x2*)p0 = (u32x2){vr0.x, vr0.y}; *(LAS u32x2*)(p0 + 8) = (u32x2){vr0.z, vr0.w}; *(LAS u32x2*)p1 = (u32x2){vr1.x, vr1.y}; *(LAS u32x2*)(p1 + 8) = (u32x2){vr1.z, vr1.w}; }
        }
    }
    const float ltot = sum_x32(lsum);
    const float inv = 1.0f / ltot;
    if (MODE == 0) {
        LAS float* xch = (LAS float*)lds;
        f32x4 sgv[NDV][4];
        if (mp == 0) {
#pragma unroll
            for (int dvb = 0; dvb < NDV; ++dvb)
#pragma unroll
                for (int g4 = 0; g4 < 4; ++g4) sgv[dvb][g4] = *(const f32x4*)(subgain + 32 * dvb + 8 * g4 + 4 * hi);
        }
        __syncthreads();
        if (mp == 1) {
#pragma unroll
            for (int dvb = 0; dvb < NDV; ++dvb)
#pragma unroll
                for (int r = 0; r < 16; ++r) { const int dv = 32 * dvb + (r & 3) + 8 * (r >> 2) + 4 * hi; xch[(wq * 128 + dv) * 32 + r32] = acc[dvb][r] * inv; }
        }
        __syncthreads();
        if (mp == 0) {
            float ss = 0.f;
#pragma unroll
            for (int dvb = 0; dvb < NDV; ++dvb)
#pragma unroll
                for (int r = 0; r < 16; ++r) { const int dv = 32 * dvb + (r & 3) + 8 * (r >> 2) + 4 * hi; const float o = acc[dvb][r] * inv - lam * xch[(wq * 128 + dv) * 32 + r32]; acc[dvb][r] = o; ss += o * o; }
            ss += shx(ss, 32, lane);
            const float rs = rsqrtf(ss * (1.0f / 128.0f) + RMS_EPS) * one_m_li;
            bf16* orow = AO + qtok * 1024 + hp * 128;
#pragma unroll
            for (int dvb = 0; dvb < NDV; ++dvb)
#pragma unroll
                for (int g4 = 0; g4 < 4; ++g4) { const int dv0 = 32 * dvb + 8 * g4 + 4 * hi; const f32x4 sg = sgv[dvb][g4];
                    u32x2 w; w.x = cvt_pk_bf16(acc[dvb][4 * g4 + 0] * rs * sg[0], acc[dvb][4 * g4 + 1] * rs * sg[1]); w.y = cvt_pk_bf16(acc[dvb][4 * g4 + 2] * rs * sg[2], acc[dvb][4 * g4 + 3] * rs * sg[3]);
                    *(u32x2*)(orow + dv0) = w; }
        }
        __syncthreads();
    } else {
        const int head = 2 * hp + mp;
        const float lse2 = mrun + __log2f(ltot);
        float wa = 0.f, wg = 1.f, lsen = lse2;
        if (gidx > 0) {
            const float la = la_pre; const float mxl = fmaxf(la, lse2);
            const float ea = fast_exp2(la - mxl), eg = fast_exp2(lse2 - mxl), tot = ea + eg;
            wa = ea / tot; wg = eg / tot; lsen = mxl + __log2f(tot);
        }
        const float sc = inv * wg;
        bf16* orow = AO + qtok * 1024 + head * 64;
#pragma unroll
        for (int dvb = 0; dvb < NDV; ++dvb)
#pragma unroll
            for (int g4 = 0; g4 < 4; ++g4) { const int dv0 = 32 * dvb + 8 * g4 + 4 * hi;
                float o0 = acc[dvb][4 * g4 + 0] * sc, o1 = acc[dvb][4 * g4 + 1] * sc, o2 = acc[dvb][4 * g4 + 2] * sc, o3 = acc[dvb][4 * g4 + 3] * sc;
                if (gidx > 0) { const u32x2 pw = pw_pre[dvb][g4]; o0 += wa * bflo(pw.x); o1 += wa * bfhi(pw.x); o2 += wa * bflo(pw.y); o3 += wa * bfhi(pw.y); }
                u32x2 w; w.x = cvt_pk_bf16(o0, o1); w.y = cvt_pk_bf16(o2, o3);
                *(u32x2*)(orow + dv0) = w; }
        if (hi == 0 && gidx < 2) LSE[qtok * 16 + head] = lsen;
        __syncthreads();
    }
}

#define XB_TMO      128
#define XB_XCNT(j)  (256  + 64 * (j))
#define XB_XSUB(j)  (1280 + 64 * (j))
#define XB_XGEN(j)  (2304 + 64 * (j))
#define XB_TOP      3328
#define XB_TOPGEN   3392
#define XCD_BAR_WORDS 3456
#define XB_SPIN_CAP (1u << 18)

__device__ __forceinline__ unsigned xb_ld(unsigned* p)              { return __hip_atomic_load(p, __ATOMIC_RELAXED, __HIP_MEMORY_SCOPE_AGENT); }
__device__ __forceinline__ unsigned xb_add(unsigned* p, unsigned v) { return __hip_atomic_fetch_add(p, v, __ATOMIC_RELAXED, __HIP_MEMORY_SCOPE_AGENT); }
__device__ __forceinline__ unsigned xb_xcc_id() { return (unsigned)__builtin_amdgcn_s_getreg((3 << 11) | 20) & 0xFu; }
#define XB_SPIN(cond, bar) do { unsigned _sp = 0; while (cond) { __builtin_amdgcn_s_sleep(1); \
    if ((++_sp & 255u) == 0u) { if (xb_ld(&(bar)[XB_TMO])) break; if (_sp > XB_SPIN_CAP) { atomicAdd(&(bar)[XB_TMO], 1u); break; } } } } while (0)

struct XcdBarrier {
    unsigned* bar; unsigned x;
    volatile LAS unsigned* st;
};

__device__ __forceinline__ XcdBarrier xcd_barrier_post(unsigned* bar, volatile LAS unsigned* st) {
    XcdBarrier b; b.bar = bar; b.x = xb_xcc_id(); b.st = st;
    if (threadIdx.x == 0) (void)xb_add(&bar[XB_XCNT(b.x)], 1u);
    return b;
}
__device__ __forceinline__ void xcd_barrier_complete(unsigned* bar, unsigned x, unsigned& nloc, unsigned& nx) {
    const unsigned G = gridDim.x * gridDim.y * gridDim.z;
    unsigned sum, cnt, mine, sp = 0u;
    for (;;) {
        sum = 0u; cnt = 0u; mine = 0u;
#pragma unroll
        for (unsigned j = 0; j < 16; ++j) { const unsigned c = xb_ld(&bar[XB_XCNT(j)]); sum += c; cnt += (c > 0u) ? 1u : 0u; mine = (j == x) ? c : mine; }
        if (sum == G) break;
        __builtin_amdgcn_s_sleep(1);
        if ((++sp & 255u) == 0u) { if (xb_ld(&bar[XB_TMO])) break; if (sp > XB_SPIN_CAP) { atomicAdd(&bar[XB_TMO], 1u); break; } }
    }
    nloc = mine > 0u ? mine : 1u; nx = cnt > 0u ? cnt : 1u;
}

__device__ __forceinline__ void xcd_barrier(const XcdBarrier& b) {
    asm volatile("s_waitcnt vmcnt(0)" ::: "memory");
    __syncthreads();
    if (threadIdx.x == 0) {
        unsigned* bar = b.bar;
        __builtin_amdgcn_s_waitcnt(0);
        unsigned nloc = b.st[0], nx = b.st[1];
        if (nloc == 0u) { xcd_barrier_complete(bar, b.x, nloc, nx); b.st[0] = nloc; b.st[1] = nx; }
        const unsigned old = xb_add(&bar[XB_XSUB(b.x)], 1u);
        const unsigned gen = old / nloc;
        if (old + 1u == (gen + 1u) * nloc) {
            __builtin_amdgcn_fence(__ATOMIC_RELEASE, "agent");
            asm volatile("s_waitcnt vmcnt(0)" ::: "memory");
            const unsigned og = xb_add(&bar[XB_TOP], 1u);
            const unsigned tg = og / nx;
            if (og + 1u == (tg + 1u) * nx) xb_add(&bar[XB_TOPGEN], 1u);
            else XB_SPIN(xb_ld(&bar[XB_TOPGEN]) == tg, bar);
            __builtin_amdgcn_fence(__ATOMIC_ACQUIRE, "agent");
            xb_add(&bar[XB_XGEN(b.x)], 1u);
            asm volatile("s_waitcnt vmcnt(0)" ::: "memory");
        } else {
            XB_SPIN(xb_ld(&bar[XB_XGEN(b.x)]) == gen, bar);
            __builtin_amdgcn_fence(__ATOMIC_ACQUIRE, "agent");
            asm volatile("s_waitcnt vmcnt(0)" ::: "memory");
        }
    }
    __syncthreads();
}

struct Args { const float* in[31]; float* out; unsigned char* ws; };


__device__ __forceinline__ void transpose_item(const float* W, int ldw, int K, int nblk, bf16* WT, int mode, int row_off, LAS float* scr, int item, int lane) {
    const int kb = item / nblk, nb = item - kb * nblk, k0 = 64 * kb, n0 = 32 * nb;
#pragma unroll 8
    for (int i = 0; i < 32; ++i) { const int kk = 2 * i + (lane >> 5); scr[kk * 33 + (lane & 31)] = W[(size_t)(k0 + kk) * ldw + n0 + (lane & 31)]; }
    asm volatile("s_waitcnt lgkmcnt(0)" ::: "memory");
    int drow;
    if (mode == 0) drow = n0;
    else if (mode == 1) { const int tile = n0 >> 8, ac = n0 & 255, wc = ac >> 6, bj = (ac >> 5) & 1; drow = 256 * tile + 128 * bj + 32 * wc; }
    else drow = 256 * (n0 >> 7) + (n0 & 127);
    drow += row_off;
    const int c = lane & 7;
#pragma unroll
    for (int j = 0; j < 4; ++j) { const int n = (lane >> 3) + 8 * j; const LAS float* s = scr + (8 * c) * 33 + n;
        u32x4 o; o.x = cvt_pk_bf16(s[0 * 33], s[1 * 33]); o.y = cvt_pk_bf16(s[2 * 33], s[3 * 33]); o.z = cvt_pk_bf16(s[4 * 33], s[5 * 33]); o.w = cvt_pk_bf16(s[6 * 33], s[7 * 33]);
        *(u32x4*)(WT + (size_t)(drow + n) * K + k0 + 8 * c) = o; }
    asm volatile("s_waitcnt lgkmcnt(0)" ::: "memory");
}

__device__ __forceinline__ int t5_bucket(int n) {
    if (n < 16) return n;
    const float nf = (float)n;
    int v = 16 + (int)(logf(nf / 16.0f) / 4.852030263919617f * 16.0f);
    return v < 31 ? v : 31;
}

__device__ __forceinline__ void norm_phase(const float* x, const float* gain, const float* shift, const float* scale, bf16* H, int bid, int ngw) {
    const int tid = opaque_tid(), lane = tid & 63, gw = bid * 8 + __builtin_amdgcn_readfirstlane(tid >> 6);
    f32x4 gv[4];
#pragma unroll
    for (int j = 0; j < 4; ++j) gv[j] = *(const f32x4*)(gain + 4 * lane + 256 * j);
    for (int row = gw; row < TOK; row += ngw) {
        const f32x4* xr = (const f32x4*)(x + (size_t)row * 1024) + lane;
        const int b = row >> 11;
        f32x4 v[4]; float s = 0.f;
#pragma unroll
        for (int j = 0; j < 4; ++j) { v[j] = xr[64 * j]; s += (v[j].x * v[j].x + v[j].y * v[j].y) + (v[j].z * v[j].z + v[j].w * v[j].w); }
        const float rstd = rsqrtf(wave_sum(s, lane) * (1.0f / 1024.0f) + RMS_EPS);
        unsigned long long* o8 = (unsigned long long*)(H + (size_t)row * 1024) + lane;
#pragma unroll
        for (int j = 0; j < 4; ++j) {
            const f32x4 sc = *(const f32x4*)(scale + (size_t)b * 6144 + 4 * lane + 256 * j), sh = *(const f32x4*)(shift + (size_t)b * 6144 + 4 * lane + 256 * j);
            const f32x4 y = v[j] * rstd * gv[j] * (sc + 1.0f) + sh;
            o8[64 * j] = (unsigned long long)cvt_pk_bf16(y.x, y.y) | ((unsigned long long)cvt_pk_bf16(y.z, y.w) << 32);
        }
    }
}

__device__ __forceinline__ void lru_coef(const u32x4 xw, const u32x4 aw, const u32x4 uw, const float (&sp)[8], const float (&bxv)[8], const float (&bav)[8], float (&l8)[8], float (&b8)[8]) {
    const float gx[8] = {bflo(xw.x), bfhi(xw.x), bflo(xw.y), bfhi(xw.y), bflo(xw.z), bfhi(xw.z), bflo(xw.w), bfhi(xw.w)};
    const float ga[8] = {bflo(aw.x), bfhi(aw.x), bflo(aw.y), bfhi(aw.y), bflo(aw.z), bfhi(aw.z), bflo(aw.w), bfhi(aw.w)};
    const float uu[8] = {bflo(uw.x), bfhi(uw.x), bflo(uw.y), bfhi(uw.y), bflo(uw.z), bfhi(uw.z), bflo(uw.w), bfhi(uw.w)};
#pragma unroll
    for (int j = 0; j < 8; ++j) {
        const float sx = __builtin_amdgcn_rcpf(1.0f + __builtin_amdgcn_exp2f(-(gx[j] + bxv[j]) * LOG2E));
        const float sa = __builtin_amdgcn_rcpf(1.0f + __builtin_amdgcn_exp2f(-(ga[j] + bav[j]) * LOG2E));
        const float la = sa * sp[j];
        const float x2 = 2.0f * la;
        const float om = (x2 > -0.02f) ? -x2 * (1.0f + x2 * (0.5f + x2 * 0.16666667f)) : 1.0f - __builtin_amdgcn_exp2f(x2 * LOG2E);
        l8[j] = la * LOG2E; b8[j] = __builtin_amdgcn_sqrtf(fmaxf(om, 0.f)) * sx * uu[j];
    }
}

__device__ __forceinline__ void norm_row_b(const bf16* xrow, bf16* hrow, const f32x4 (&gv)[2][2], const f32x4 (&scv)[2][2], const f32x4 (&shv)[2][2], int lane) {
    f32x4 v[2][2]; float s = 0.f;
#pragma unroll
    for (int j = 0; j < 2; ++j) { const u32x4 w = *(const u32x4*)(xrow + 8 * lane + 512 * j);
        v[j][0] = (f32x4){bflo(w.x), bfhi(w.x), bflo(w.y), bfhi(w.y)}; v[j][1] = (f32x4){bflo(w.z), bfhi(w.z), bflo(w.w), bfhi(w.w)};
#pragma unroll
        for (int n = 0; n < 2; ++n) s += (v[j][n].x * v[j][n].x + v[j][n].y * v[j][n].y) + (v[j][n].z * v[j][n].z + v[j][n].w * v[j][n].w); }
    const float rstd = rsqrtf(wave_sum(s, lane) * (1.0f / 1024.0f) + RMS_EPS);
#pragma unroll
    for (int j = 0; j < 2; ++j) { const f32x4 y0 = v[j][0] * rstd * gv[j][0] * scv[j][0] + shv[j][0], y1 = v[j][1] * rstd * gv[j][1] * scv[j][1] + shv[j][1];
        u32x4 w; w.x = cvt_pk_bf16(y0.x, y0.y); w.y = cvt_pk_bf16(y0.z, y0.w); w.z = cvt_pk_bf16(y1.x, y1.y); w.w = cvt_pk_bf16(y1.z, y1.w);
        *(u32x4*)(hrow + 8 * lane + 512 * j) = w; }
}
template <int R>
__device__ __forceinline__ void norm_rows_b(const bf16* xrow, bf16* hrow, const f32x4 (&gv)[2][2], const f32x4 (&scv)[2][2], const f32x4 (&shv)[2][2], int lane) {
    u32x4 w[R][2];
#pragma unroll
    for (int q = 0; q < R; ++q)
#pragma unroll
        for (int j = 0; j < 2; ++j) w[q][j] = *(const u32x4*)(xrow + (size_t)q * 1024 + 8 * lane + 512 * j);
    f32x4 v[R][2][2]; float ssq[R];
#pragma unroll
    for (int q = 0; q < R; ++q) { float s_ = 0.f;
#pragma unroll
        for (int j = 0; j < 2; ++j) { const u32x4 ww = w[q][j];
            v[q][j][0] = (f32x4){bflo(ww.x), bfhi(ww.x), bflo(ww.y), bfhi(ww.y)}; v[q][j][1] = (f32x4){bflo(ww.z), bfhi(ww.z), bflo(ww.w), bfhi(ww.w)};
#pragma unroll
            for (int n = 0; n < 2; ++n) s_ += (v[q][j][n].x * v[q][j][n].x + v[q][j][n].y * v[q][j][n].y) + (v[q][j][n].z * v[q][j][n].z + v[q][j][n].w * v[q][j][n].w); }
        ssq[q] = s_; }
#pragma unroll
    for (int o = 1; o < 64; o <<= 1)
#pragma unroll
        for (int q = 0; q < R; ++q) ssq[q] += shx(ssq[q], o, lane);
#pragma unroll
    for (int q = 0; q < R; ++q) { const float rstd = rsqrtf(ssq[q] * (1.0f / 1024.0f) + RMS_EPS);
#pragma unroll
        for (int j = 0; j < 2; ++j) { const f32x4 y0 = v[q][j][0] * rstd * gv[j][0] * scv[j][0] + shv[j][0], y1 = v[q][j][1] * rstd * gv[j][1] * scv[j][1] + shv[j][1];
            u32x4 o_; o_.x = cvt_pk_bf16(y0.x, y0.y); o_.y = cvt_pk_bf16(y0.z, y0.w); o_.z = cvt_pk_bf16(y1.x, y1.y); o_.w = cvt_pk_bf16(y1.z, y1.w);
            *(u32x4*)(hrow + (size_t)q * 1024 + 8 * lane + 512 * j) = o_; } }
}
#define NORM_B_LOAD_GAIN(gain) f32x4 gv[2][2]; _Pragma("unroll") for (int j = 0; j < 2; ++j) _Pragma("unroll") for (int n = 0; n < 2; ++n) gv[j][n] = *(const f32x4*)((gain) + 8 * lane + 512 * j + 4 * n);
#define NORM_B_LOAD_MOD(b) f32x4 scv[2][2], shv[2][2]; _Pragma("unroll") for (int j = 0; j < 2; ++j) _Pragma("unroll") for (int n = 0; n < 2; ++n) { \
        scv[j][n] = *(const f32x4*)(scale + (size_t)(b) * 6144 + 8 * lane + 512 * j + 4 * n) + 1.0f; shv[j][n] = *(const f32x4*)(shift + (size_t)(b) * 6144 + 8 * lane + 512 * j + 4 * n); }
__device__ __forceinline__ void norm_phase_b(const bf16* xb, const float* gain, const float* shift, const float* scale, bf16* H, int bid, int ngw) {
    const int tid = opaque_tid(), lane = tid & 63, gw = bid * 8 + __builtin_amdgcn_readfirstlane(tid >> 6);
    NORM_B_LOAD_GAIN(gain)
    for (int slab = gw; slab < TOK / 32; slab += ngw) {
        const int row0 = slab * 32;
        NORM_B_LOAD_MOD(row0 >> 11)
        for (int r = 0; r < 32; r += 4) norm_rows_b<4>(xb + (size_t)(row0 + r) * 1024, H + (size_t)(row0 + r) * 1024, gv, scv, shv, lane);
    }
}

__device__ __forceinline__ void norm_panels(const bf16* xb, const float* gain, const float* shift, const float* scale, bf16* H, int bid, int G) {
    const int tid = opaque_tid(), lane = tid & 63, wave = __builtin_amdgcn_readfirstlane(tid >> 6);
    NORM_B_LOAD_GAIN(gain)
    for (int pm = bid; pm < 256; pm += G) {
        NORM_B_LOAD_MOD(pm >> 3)
        const int row0 = pm * 256 + wave * 32;
        for (int r = 0; r < 32; r += 4) norm_rows_b<4>(xb + (size_t)(row0 + r) * 1024, H + (size_t)(row0 + r) * 1024, gv, scv, shv, lane);
    }
}

__global__ void __launch_bounds__(NT_, 2) fwd_mega(Args args) {
    extern __shared__ __attribute__((aligned(16))) unsigned char lds_raw[];
    LAS unsigned char* lds = (LAS unsigned char*)lds_raw;
    cg::grid_group grid = cg::this_grid();
#define GSYNC_HIP() do { asm volatile("s_waitcnt vmcnt(0) lgkmcnt(0)" ::: "memory"); grid.sync(); } while (0)
#define GSYNC() do { XcdBarrier xb_; xb_.bar = (unsigned*)(ws + WS_BAR); xb_.x = xb_xcc_id(); xb_.st = (volatile LAS unsigned*)(lds + LDS_XB_OFF); xcd_barrier(xb_); } while (0)
    const int G = gridDim.x, bid = blockIdx.x;
    if (threadIdx.x < 4) ((LAS unsigned*)(lds + LDS_XB_OFF))[threadIdx.x] = 0u;
    __syncthreads();
    (void)xcd_barrier_post((unsigned*)(args.ws + WS_BAR), (volatile LAS unsigned*)(lds + LDS_XB_OFF));
    const int ngw = G * 8, ngt = G * NT_;
#define PHASE_IDS const int tid = opaque_tid(), lane = tid & 63, wave = __builtin_amdgcn_readfirstlane(tid >> 6), gw = bid * 8 + wave, gtid = bid * NT_ + tid; (void)lane; (void)wave; (void)gw; (void)gtid;
    unsigned char* ws = args.ws;
    const float* x_in = args.in[0]; float* xo = args.out;
#define scal ((float*)(ws + WS_SCAL))
#define mod ((float*)(ws + WS_MOD))
#define biasT ((float*)(ws + WS_BIAS))
#define CS ((float*)(ws + WS_CS))
#define CH ((float*)(ws + WS_CH))
#define Hb ((bf16*)(ws + WS_H))
#define HID ((bf16*)(ws + WS_BIG))
#define QKb ((bf16*)(ws + WS_QK))
#define VTb ((bf16*)(ws + WS_VT))
#define AOb ((bf16*)(ws + WS_AO))
#define GYb ((bf16*)(ws + WS_GY))
#define Ub ((bf16*)(ws + WS_U))
#define UCb ((bf16*)(ws + WS_UC))
#define LAb ((bf16*)(ws + WS_LA))
#define BVb ((bf16*)(ws + WS_BV))
#define LSEb ((float*)(ws + WS_LSE))
#define XBb ((bf16*)(ws + WS_XB))

    {
        PHASE_IDS
        LAS float* scr = (LAS float*)(lds + wave * 8448);
        constexpr int I_W1 = 16 * 128, I_W2 = 64 * 32, I_QK = 16 * 64, I_SQ = 16 * 32, I_G = 4 * 8;
        constexpr int NITEMS = 4 * (I_W1 + I_W2) + 2 * (I_QK + 2 * I_SQ) + (I_QK + 8 * I_G + I_SQ) + (3 * (I_QK + I_SQ) + I_SQ);
#ifndef SK_TR
        for (int it = gw; it < NITEMS; it += ngw) {
            int r = it;
            if (r < 4 * I_W1) { const int l = r / I_W1; transpose_item(args.in[7] + (size_t)l * 1024 * 4096, 4096, 1024, 128, (bf16*)(ws + W_W1) + (size_t)l * 4096 * 1024, 0, 0, scr, r % I_W1, lane); continue; } r -= 4 * I_W1;
            if (r < 4 * I_W2) { const int l = r / I_W2; transpose_item(args.in[8] + (size_t)l * 4096 * 1024, 1024, 4096, 32, (bf16*)(ws + W_W2) + (size_t)l * 1024 * 4096, 0, 0, scr, r % I_W2, lane); continue; } r -= 4 * I_W2;
            if (r < 2 * I_QK) { const int s = r / I_QK; transpose_item(args.in[9] + (size_t)s * 1024 * 3072, 3072, 1024, 64, (bf16*)(ws + W_DAQK) + (size_t)s * 2048 * 1024, 1, 0, scr, r % I_QK, lane); continue; } r -= 2 * I_QK;
            if (r < 2 * I_SQ) { const int s = r / I_SQ; transpose_item(args.in[9] + (size_t)s * 1024 * 3072 + 2048, 3072, 1024, 32, (bf16*)(ws + W_DAV) + (size_t)s * 1024 * 1024, 0, 0, scr, r % I_SQ, lane); continue; } r -= 2 * I_SQ;
            if (r < 2 * I_SQ) { const int s = r / I_SQ; transpose_item(args.in[10] + (size_t)s * 1024 * 1024, 1024, 1024, 32, (bf16*)(ws + W_DAO) + (size_t)s * 1024 * 1024, 0, 0, scr, r % I_SQ, lane); continue; } r -= 2 * I_SQ;
            if (r < I_QK) { transpose_item(args.in[18], 2048, 1024, 64, (bf16*)(ws + W_LIN), 0, 0, scr, r, lane); continue; } r -= I_QK;
            if (r < 8 * I_G) { const int sm = r / I_G, blk = sm >> 1, gate = sm & 1;
                transpose_item(args.in[gate ? 23 : 21] + (size_t)blk * 65536, 256, 256, 8, (bf16*)(ws + W_LG), 2, 512 * blk + 128 * gate, scr, r % I_G, lane); continue; } r -= 8 * I_G;
            if (r < I_SQ) { transpose_item(args.in[26], 1024, 1024, 32, (bf16*)(ws + W_LOUT), 0, 0, scr, r, lane); continue; } r -= I_SQ;
            if (r < 3 * I_QK) { const int g = r / I_QK; transpose_item(args.in[27] + (size_t)g * 3072, 9216, 1024, 64, (bf16*)(ws + W_DLQK) + (size_t)g * 2048 * 1024, 1, 0, scr, r % I_QK, lane); continue; } r -= 3 * I_QK;
            if (r < 3 * I_SQ) { const int g = r / I_SQ; transpose_item(args.in[27] + (size_t)g * 3072 + 2048, 9216, 1024, 32, (bf16*)(ws + W_DLV) + (size_t)g * 1024 * 1024, 0, 0, scr, r % I_SQ, lane); continue; } r -= 3 * I_SQ;
            transpose_item(args.in[28], 1024, 1024, 32, (bf16*)(ws + W_DLO), 0, 0, scr, r, lane);
        }
#endif
        for (int i = gtid; i < 16 * 2048; i += ngt) { const int col = i >> 11, dist = i & 2047; biasT[i] = args.in[2][t5_bucket(dist) * 16 + col] * LOG2E; }
        if (gtid < 1024) ((float*)(ws + WS_SP))[gtid] = -8.0f * log1pf(expf(-args.in[25][gtid]));
        if (bid == 0 && wave == 0) {
            for (int s = 0; s < 2; ++s) {
                const float a = wave_sum(args.in[13][s * 64 + lane] * args.in[14][s * 64 + lane], lane);
                const float b2 = wave_sum(args.in[15][s * 64 + lane] * args.in[16][s * 64 + lane], lane);
                const int layer = 3 * s; const float li = 0.8f - 0.6f * expf(-0.3f * (float)layer);
                if (lane == 0) scal[s] = expf(a) - expf(b2) + li;
            }
        }
        __syncthreads();
#ifndef SK_ADALN
        {
            LAS float* sc = (LAS float*)lds; LAS float* red = (LAS float*)(lds + 131072);
            const float* cin = args.in[1];
            for (int i = tid; i < 32768; i += NT_) { const int b = i & 31, k = i >> 5; const float v = cin[b * 1024 + k]; sc[k * 32 + b] = v / (1.0f + __expf(-v)); }
            __syncthreads();
            for (int item = bid; item < 768; item += G) {
                const int l = item / 192, nb = item - l * 192, col = tid & 31, kg = tid >> 5;
                float a[32];
#pragma unroll
                for (int b = 0; b < 32; ++b) a[b] = 0.f;
                const float* wp = args.in[3] + ((size_t)l * 1024 + kg * 64) * 6144 + nb * 32 + col;
                for (int kk = 0; kk < 64; ++kk) {
                    const float w = wp[(size_t)kk * 6144]; const LAS float* row = sc + (kg * 64 + kk) * 32;
#pragma unroll
                    for (int b4 = 0; b4 < 8; ++b4) { const f32x4 s4 = *(const LAS f32x4*)(row + 4 * b4); a[4 * b4 + 0] += w * s4[0]; a[4 * b4 + 1] += w * s4[1]; a[4 * b4 + 2] += w * s4[2]; a[4 * b4 + 3] += w * s4[3]; }
                }
#pragma unroll
                for (int b = 0; b < 32; ++b) a[b] += shx(a[b], 32, lane);
                for (int w = 0; w < 8; ++w) {
                    if (wave == w && lane < 32) {
#pragma unroll
                        for (int b = 0; b < 32; ++b) { LAS float* p = red + b * 32 + col; *p = (w == 0 ? 0.f : *p) + a[b]; }
                    }
                    __syncthreads();
                }
                for (int i = tid; i < 1024; i += NT_) { const int b = i >> 5, cc = i & 31; mod[((size_t)l * 32 + b) * 6144 + nb * 32 + cc] = red[b * 32 + cc] + args.in[4][l * 6144 + nb * 32 + cc]; }
                __syncthreads();
            }
        }
#endif
    }
    if (args.ws == nullptr) GSYNC_HIP();
    GSYNC();

#pragma nounroll
    for (int layer = 0; layer < 4; ++layer) {
        asm volatile("" : "+s"(ws));
        const int kind = layer % 3, slot = layer / 3;
        const float* modl = mod + (size_t)layer * 32 * 6144;
        if (layer == 0) norm_phase(x_in, args.in[5], modl, modl + 1024, Hb, bid, ngw);
        else norm_phase_b(XBb, args.in[5] + layer * 1024, modl, modl + 1024, Hb, bid, ngw);
        GSYNC();
        const bf16* mixA; const bf16* mixW;
        if (kind == 1) {
#ifndef SK_L_WIN
            {
                pg8::Gemm g{Hb, (const bf16*)(ws + W_LIN), 1024, 1024, 1024, 256, 8, 1, 0}; pg8::StaticOrder S; S.init(256, 8, G, bid);
                pg8::EpiYU E{GYb, Ub}; pg8::gemm_phase<pg8::EpiYU, pg8::StaticOrder>(lds, g, S, E);
            }
#endif
            GSYNC();
#ifndef SK_L_CONV
            {
                PHASE_IDS
                const int ch = (gtid & 127) * 8;
                float cw[4][8], cb[8];
#pragma unroll
                for (int j = 0; j < 8; ++j) { cb[j] = args.in[20][ch + j];
#pragma unroll
                    for (int tap = 0; tap < 4; ++tap) cw[tap][j] = args.in[19][tap * 1024 + ch + j]; }
                for (int it = gtid; it < 131072; it += ngt) {
                    const int bc = it >> 7; const size_t t0 = (size_t)(bc >> 5) * 2048 + (size_t)(bc & 31) * 64; const bool halo = (bc & 31) != 0;
                    const u32x4 z4 = (u32x4){0u, 0u, 0u, 0u};
                    u32x4 p1 = halo ? *(const u32x4*)(Ub + (t0 - 1) * 1024 + ch) : z4, p2 = halo ? *(const u32x4*)(Ub + (t0 - 2) * 1024 + ch) : z4, p3 = halo ? *(const u32x4*)(Ub + (t0 - 3) * 1024 + ch) : z4;
#pragma unroll 4
                    for (int st = 0; st < 64; ++st) {
                        const u32x4 c0 = *(const u32x4*)(Ub + (t0 + st) * 1024 + ch);
                        float a[8];
#pragma unroll
                        for (int j = 0; j < 8; ++j) a[j] = cb[j];
#define CONV_TAP(tap, uw) do { a[0] += cw[tap][0] * bflo(uw.x); a[1] += cw[tap][1] * bfhi(uw.x); a[2] += cw[tap][2] * bflo(uw.y); a[3] += cw[tap][3] * bfhi(uw.y); \
                            a[4] += cw[tap][4] * bflo(uw.z); a[5] += cw[tap][5] * bfhi(uw.z); a[6] += cw[tap][6] * bflo(uw.w); a[7] += cw[tap][7] * bfhi(uw.w); } while (0)
                        CONV_TAP(0, c0); CONV_TAP(1, p1); CONV_TAP(2, p2); CONV_TAP(3, p3);
#undef CONV_TAP
                        u32x4 w; w.x = cvt_pk_bf16(a[0], a[1]); w.y = cvt_pk_bf16(a[2], a[3]); w.z = cvt_pk_bf16(a[4], a[5]); w.w = cvt_pk_bf16(a[6], a[7]);
                        *(u32x4*)(UCb + (t0 + st) * 1024 + ch) = w;
                        p3 = p2; p2 = p1; p1 = c0;
                    }
                }
            }
#endif
            GSYNC();
#ifndef SK_L_GATES
            {
                pg8::Gemm g{UCb, (const bf16*)(ws + W_LG), 1024, 256, 256, 256, 8, 1, 1}; pg8::StaticOrder S; S.init(256, 8, G, bid);
                pg8::EpiGates E{LAb, BVb}; pg8::gemm_phase<pg8::EpiGates, pg8::StaticOrder>(lds, g, S, E);
            }
#endif
            GSYNC();
#ifndef SK_L_SCAN
            { PHASE_IDS
            for (int it = gtid; it < 131072; it += ngt) {
                const int ch = (it & 127) * 8, bc = it >> 7; const size_t t0 = (size_t)(bc >> 5) * 2048 + (size_t)(bc & 31) * 64;
                float h[8], sl[8], sp[8], bxv[8], bav[8];
#pragma unroll
                for (int j = 0; j < 8; ++j) { h[j] = 0.f; sl[j] = 0.f; sp[j] = ((const float*)(ws + WS_SP))[ch + j]; bxv[j] = args.in[22][ch + j]; bav[j] = args.in[24][ch + j]; }
#pragma unroll 2
                for (int st = 0; st < 64; ++st) {
                    const u32x4 lw = *(const u32x4*)(LAb + (t0 + st) * 1024 + ch), bw = *(const u32x4*)(BVb + (t0 + st) * 1024 + ch), uw = *(const u32x4*)(UCb + (t0 + st) * 1024 + ch);
                    float l8[8], b8[8]; lru_coef(lw, bw, uw, sp, bxv, bav, l8, b8);
#pragma unroll
                    for (int j = 0; j < 8; ++j) { sl[j] += l8[j]; h[j] = fast_exp2(l8[j]) * h[j] + b8[j]; }
                }
                float* cs = CS + (size_t)bc * 1024 + ch; float* chp = CH + (size_t)bc * 1024 + ch;
                *(f32x4*)cs = (f32x4){sl[0], sl[1], sl[2], sl[3]}; *(f32x4*)(cs + 4) = (f32x4){sl[4], sl[5], sl[6], sl[7]};
                *(f32x4*)chp = (f32x4){h[0], h[1], h[2], h[3]}; *(f32x4*)(chp + 4) = (f32x4){h[4], h[5], h[6], h[7]};
            } }
            GSYNC();
            { PHASE_IDS
            for (int it = gtid; it < 131072; it += ngt) {
                const int ch = (it & 127) * 8, bc = it >> 7, bb = bc >> 5, chunk = bc & 31; const size_t t0 = (size_t)bb * 2048 + (size_t)chunk * 64;
                float h[8], sp[8], bxv[8], bav[8];
#pragma unroll
                for (int j = 0; j < 8; ++j) { h[j] = 0.f; sp[j] = ((const float*)(ws + WS_SP))[ch + j]; bxv[j] = args.in[22][ch + j]; bav[j] = args.in[24][ch + j]; }
#pragma unroll 8
                for (int cc = 0; cc < chunk; ++cc) {
                    const float* cs = CS + (size_t)(bb * 32 + cc) * 1024 + ch; const float* chp = CH + (size_t)(bb * 32 + cc) * 1024 + ch;
                    const f32x4 s0 = *(const f32x4*)cs, s1 = *(const f32x4*)(cs + 4), h0 = *(const f32x4*)chp, h1 = *(const f32x4*)(chp + 4);
#pragma unroll
                    for (int j = 0; j < 4; ++j) { h[j] = fast_exp2(s0[j]) * h[j] + h0[j]; h[4 + j] = fast_exp2(s1[j]) * h[4 + j] + h1[j]; }
                }
#pragma unroll 2
                for (int st = 0; st < 64; ++st) {
                    const u32x4 lw = *(const u32x4*)(LAb + (t0 + st) * 1024 + ch), bw = *(const u32x4*)(BVb + (t0 + st) * 1024 + ch), uw = *(const u32x4*)(UCb + (t0 + st) * 1024 + ch), gw4 = *(const u32x4*)(GYb + (t0 + st) * 1024 + ch);
                    float l8[8], b8[8]; lru_coef(lw, bw, uw, sp, bxv, bav, l8, b8);
                    const float g8[8] = {bflo(gw4.x), bfhi(gw4.x), bflo(gw4.y), bfhi(gw4.y), bflo(gw4.z), bfhi(gw4.z), bflo(gw4.w), bfhi(gw4.w)};
                    float o[8];
#pragma unroll
                    for (int j = 0; j < 8; ++j) { h[j] = fast_exp2(l8[j]) * h[j] + b8[j]; o[j] = h[j] * g8[j]; }
                    u32x4 w; w.x = cvt_pk_bf16(o[0], o[1]); w.y = cvt_pk_bf16(o[2], o[3]); w.z = cvt_pk_bf16(o[4], o[5]); w.w = cvt_pk_bf16(o[6], o[7]);
                    *(u32x4*)(Ub + (t0 + st) * 1024 + ch) = w;
                }
            } }
#endif
            GSYNC();
            mixA = Ub; mixW = (const bf16*)(ws + W_LOUT);
        } else {
            const int ngroups = (kind == 0) ? 1 : 3;
#pragma nounroll
            for (int gi = 0; gi < ngroups; ++gi) {
                const int dil = (kind == 0) ? 1 : (gi == 0 ? 1 : (gi == 1 ? 4 : 16));
                const bf16* wqk = (kind == 0) ? (const bf16*)(ws + W_DAQK) + (size_t)slot * 2048 * 1024 : (const bf16*)(ws + W_DLQK) + (size_t)gi * 2048 * 1024;
                const bf16* wv = (kind == 0) ? (const bf16*)(ws + W_DAV) + (size_t)slot * 1024 * 1024 : (const bf16*)(ws + W_DLV) + (size_t)gi * 1024 * 1024;
                const float* qg = (kind == 0) ? args.in[11] + slot * 64 : args.in[29];
                const float* kg = (kind == 0) ? args.in[12] + slot * 64 : args.in[30];
#ifndef SK_GQK
                {
                    pg8::Gemm g{Hb, wqk, 1024, 1024, 1024, 256, 8, 1, 0}; pg8::StaticOrder S; S.init(256, 8, G, bid);
                    pg8::EpiQK E{QKb, qg, kg}; pg8::gemm_phase<pg8::EpiQK, pg8::StaticOrder>(lds, g, S, E);
                }
#endif
#ifndef SK_GVT
                {
                    pg8::Gemm g{wv, Hb, 1024, dil * 1024, 1024, 4, 256, dil, 0}; pg8::StaticOrder S; S.init(4, 256, G, bid);
                    pg8::EpiBf16<0> E{VTb, (size_t)TOK}; pg8::gemm_phase<pg8::EpiBf16<0>, pg8::StaticOrder>(lds, g, S, E);
                }
#endif
                GSYNC();
                if (kind == 0) {
#ifndef SK_ATT0
                    const float lam = scal[slot]; const float li = 0.8f - 0.6f * expf(-0.3f * (float)layer);
                    int last_hp = -1;
                    if (G == 256) {
                        const int xcd = bid & 7, bslot = bid >> 3, grp = bslot >> 3, pp = bslot & 7;
                        for (int rnd = 0; rnd < 8; ++rnd) {
                            const int bh = 32 * xcd + 4 * rnd + grp;
                            attn_unit<0>(lds, QKb, VTb, biasT, bh >> 3, bh & 7, 0, 1, 15 - pp, AOb, LSEb, 0, lam, args.in[17] + slot * 128, 1.0f - li, (bh & 7) != last_hp); last_hp = bh & 7;
                            attn_unit<0>(lds, QKb, VTb, biasT, bh >> 3, bh & 7, 0, 1, pp, AOb, LSEb, 0, lam, args.in[17] + slot * 128, 1.0f - li, false);
                        }
                    } else
                    for (int u = bid; u < 4096; u += G) { const int bh = u & 255, r = u >> 8;
                        attn_unit<0>(lds, QKb, VTb, biasT, bh >> 3, bh & 7, 0, 1, 15 - r, AOb, LSEb, 0, lam, args.in[17] + slot * 128, 1.0f - li, (bh & 7) != last_hp); last_hp = bh & 7; }
#endif
                } else {
#ifndef SK_ATT1
                    int last_hp = -1;
                    for (int u = bid; u < 4096; u += G) { const int bh = u & 255, r = u >> 8; const int c = r % dil, jb = r / dil;
                        attn_unit<1>(lds, QKb, VTb, biasT, bh >> 3, bh & 7, c, dil, jb, AOb, LSEb, gi, 0.f, nullptr, 0.f, (bh & 7) != last_hp); last_hp = bh & 7; }
#endif
                }
                GSYNC();
            }
            mixA = AOb; mixW = (kind == 0) ? (const bf16*)(ws + W_DAO) + (size_t)slot * 1024 * 1024 : (const bf16*)(ws + W_DLO);
        }
#ifndef SK_GRES
        {
            pg8::Gemm g{mixA, mixW, 1024, 1024, 1024, 256, 4, 1, 0}; pg8::RowOrder S; S.init(256, 4, G, bid);
            pg8::EpiResid E{(layer == 0) ? x_in : (const float*)nullptr, XBb, (float*)nullptr, XBb, modl + 2048}; pg8::gemm_phase<pg8::EpiResid, pg8::RowOrder>(lds, g, S, E);
            norm_panels(XBb, args.in[6] + layer * 1024, modl + 3072, modl + 4096, Hb, bid, G);
        }
#endif
        GSYNC();
#ifndef SK_GUP
        {
            pg8::Gemm g{Hb, (const bf16*)(ws + W_W1) + (size_t)layer * 4096 * 1024, 1024, 1024, 1024, 256, 16, 1, 0}; pg8::StaticOrder S; S.init(256, 16, G, bid);
            pg8::EpiBf16<1> E{HID, (size_t)4096}; pg8::gemm_phase<pg8::EpiBf16<1>, pg8::StaticOrder>(lds, g, S, E);
        }
#endif
        GSYNC();
#ifndef SK_GDOWN
        {
            pg8::Gemm g{HID, (const bf16*)(ws + W_W2) + (size_t)layer * 1024 * 4096, 4096, 4096, 4096, 256, 4, 1, 0}; pg8::StaticOrder S; S.init(256, 4, G, bid);
            pg8::EpiResid E{(const float*)nullptr, XBb, (layer == 3) ? xo : (float*)nullptr, XBb, modl + 5120}; pg8::gemm_phase<pg8::EpiResid, pg8::StaticOrder>(lds, g, S, E);
        }
#endif
        if (layer < 3) GSYNC();
    }
}

extern "C" void kernel_launch(void* const* d_in, const int* in_sizes, int n_in, void* d_out, int out_size, void* d_ws, size_t ws_size, hipStream_t stream) {
    static int grid_blocks = 0;
    if (grid_blocks == 0) {
        if (n_in != 31 || out_size != TOK * DM || ws_size < WS_END) { fprintf(stderr, "kernel_launch: unexpected shapes (n_in %d out %d ws %zu)\n", n_in, out_size, ws_size); grid_blocks = -1; return; }
        int dev = 0, cus = 0, per_cu = 0;
        hipGetDevice(&dev);
        hipDeviceGetAttribute(&cus, hipDeviceAttributeMultiprocessorCount, dev);
        if (hipFuncSetAttribute((const void*)fwd_mega, hipFuncAttributeMaxDynamicSharedMemorySize, LDS_BYTES) != hipSuccess) { fprintf(stderr, "kernel_launch: hipFuncSetAttribute failed\n"); }
        if (hipOccupancyMaxActiveBlocksPerMultiprocessor(&per_cu, (const void*)fwd_mega, NT_, LDS_BYTES) != hipSuccess || per_cu < 1) { fprintf(stderr, "kernel_launch: occupancy query gave %d\n", per_cu); per_cu = 1; }
        (void)hipGetLastError();
        grid_blocks = cus * per_cu;
    }
    if (grid_blocks < 0) return;
    if (hipMemsetAsync((char*)d_ws + WS_BAR, 0, 16384, stream) != hipSuccess) { fprintf(stderr, "kernel_launch: memset of the barrier words failed\n"); return; }
    Args a{};
    for (int i = 0; i < 31; ++i) a.in[i] = (const float*)d_in[i];
    a.out = (float*)d_out; a.ws = (unsigned char*)d_ws;
    void* kargs[] = {&a};
    hipError_t e = hipLaunchCooperativeKernel((const void*)fwd_mega, dim3(grid_blocks), dim3(NT_), kargs, LDS_BYTES, stream);
    if (e != hipSuccess) fprintf(stderr, "cooperative launch failed: %s (grid %d)\n", hipGetErrorString(e), grid_blocks);
}
```

```cpp
#include <hip/hip_runtime.h>
#include <hip/hip_cooperative_groups.h>
#include <cstdio>
#include <cstdint>
namespace cg = cooperative_groups;

#define LAS __attribute__((address_space(3)))
#define GAS __attribute__((address_space(1)))
typedef unsigned short bf16;
typedef short bf16x8 __attribute__((ext_vector_type(8)));
typedef short s16x4 __attribute__((ext_vector_type(4)));
typedef float f32x4 __attribute__((ext_vector_type(4)));
typedef float f32x16 __attribute__((ext_vector_type(16)));
typedef unsigned u32x4 __attribute__((ext_vector_type(4)));
typedef unsigned u32x2 __attribute__((ext_vector_type(2)));

constexpr int NT_ = 512;
constexpr int TOK = 65536, DM = 1024, SEQ = 2048, NB = 32, DFF = 4096;
constexpr float LOG2E = 1.4426950408889634f;
constexpr float RMS_EPS = 1e-6f;
constexpr int LDS_XB_OFF = 139264 - 16;
constexpr int LDS_BYTES = 139264;

constexpr size_t MiB = 1u << 20;
constexpr size_t WS_SCAL = 0;
constexpr size_t WS_BAR = 128 * 1024;
constexpr size_t WS_SP = 64 * 1024;
constexpr size_t WS_MOD = 1 * MiB;
constexpr size_t WS_BIAS = 4 * MiB;
constexpr size_t WS_CS = 5 * MiB;
constexpr size_t WS_CH = 9 * MiB;
constexpr size_t WS_W = 16 * MiB;
constexpr size_t W_W1 = WS_W;
constexpr size_t W_W2 = W_W1 + 32 * MiB;
constexpr size_t W_DAQK = W_W2 + 32 * MiB;
constexpr size_t W_DAV = W_DAQK + 8 * MiB;
constexpr size_t W_DAO = W_DAV + 4 * MiB;
constexpr size_t W_LIN = W_DAO + 4 * MiB;
constexpr size_t W_LG = W_LIN + 4 * MiB;
constexpr size_t W_LOUT = W_LG + 1 * MiB;
constexpr size_t W_DLQK = W_LOUT + 2 * MiB;
constexpr size_t W_DLV = W_DLQK + 12 * MiB;
constexpr size_t W_DLO = W_DLV + 6 * MiB;
constexpr size_t W_END = W_DLO + 2 * MiB;
static_assert(W_END <= 128 * MiB, "weights fit");
constexpr size_t WS_H = 128 * MiB;
constexpr size_t WS_BIG = 256 * MiB;
constexpr size_t WS_QK = WS_BIG;
constexpr size_t WS_VT = WS_BIG + 256 * MiB;
constexpr size_t WS_AO = WS_BIG + 384 * MiB;
constexpr size_t WS_GY = WS_BIG;
constexpr size_t WS_U = WS_BIG + 128 * MiB;
constexpr size_t WS_UC = WS_BIG + 256 * MiB;
constexpr size_t WS_LA = WS_BIG + 384 * MiB;
constexpr size_t WS_BV = WS_H;
constexpr size_t WS_LSE = 768 * MiB;
constexpr size_t WS_XB = 776 * MiB;
constexpr size_t WS_END = 904 * MiB;

__device__ __forceinline__ int opaque_tid() { int t = threadIdx.x; asm volatile("" : "+v"(t)); return t; }
typedef float f32x2_t __attribute__((ext_vector_type(2))); typedef __bf16 bf16x2_t __attribute__((ext_vector_type(2)));
__device__ __forceinline__ unsigned cvt_pk_bf16(float lo, float hi) { f32x2_t v = {lo, hi}; bf16x2_t b = __builtin_convertvector(v, bf16x2_t); return __builtin_bit_cast(unsigned, b); }
__device__ __forceinline__ float shx(float v, int m, int lane) { return __int_as_float(__builtin_amdgcn_ds_bpermute((lane ^ m) << 2, __float_as_int(v))); }
__device__ __forceinline__ float wave_sum(float v, int lane) {
#pragma unroll
    for (int o = 1; o < 64; o <<= 1) v += shx(v, o, lane);
    return v;
}
__device__ __forceinline__ float max_x32(float v) { auto rr = __builtin_amdgcn_permlane32_swap(__float_as_uint(v), __float_as_uint(v), false, false); return fmaxf(__uint_as_float(rr[0]), __uint_as_float(rr[1])); }
__device__ __forceinline__ float sum_x32(float v) { auto rr = __builtin_amdgcn_permlane32_swap(__float_as_uint(v), __float_as_uint(v), false, false); return __uint_as_float(rr[0]) + __uint_as_float(rr[1]); }
__device__ __forceinline__ float bf2f(unsigned short h) { return __uint_as_float(((unsigned)h) << 16); }
__device__ __forceinline__ float bflo(unsigned w) { return __uint_as_float(w << 16); }
__device__ __forceinline__ float bfhi(unsigned w) { return __uint_as_float(w & 0xffff0000u); }
__device__ __forceinline__ float fast_exp2(float x) { return __builtin_amdgcn_exp2f(x); }
__device__ __forceinline__ float sigmoidf_(float x) { return 1.0f / (1.0f + __expf(-x)); }

namespace pg8 {
constexpr int BM = 256, BK = 64, HALF = 128, HTB = HALF * BK * 2, STAGE_BYTES = 8 * HTB, NXCD = 8, WGM = 8;
__host__ __device__ __forceinline__ int lds_byte(int r, int c) { const int st = (r >> 4) * 2 + (c >> 5), rr = r & 15, cc = c & 31, ob = rr * 64 + cc * 2; return st * 1024 + (ob ^ (((ob >> 9) & 1) << 5)); }
__host__ __device__ __forceinline__ void stage_rc(int b, int& R, int& C) { const int st = b / 1024, sb = b % 1024, swz = sb ^ (((sb >> 9) & 1) << 5); R = (st >> 1) * 16 + swz / 64; C = (st & 1) * 32 + (swz % 64) / 2; }
__host__ __device__ __forceinline__ int perm32(int rho) { const int n = rho >> 4, i = rho & 15; return 8 * (i >> 2) + 4 * n + (i & 3); }

struct Unit { int pm, pn; };
struct Gemm { const bf16* A; const bf16* Bt; int lda, ldb, K, nM, nN, dil, agrp; };

__device__ __forceinline__ const char* baseA(const Gemm& g, const Unit& u) {
    return (const char*)(g.A + (size_t)u.pm * 256 * g.lda + (g.agrp ? (u.pn >> 1) * 256 : 0));
}
__device__ __forceinline__ const char* baseB(const Gemm& g, const Unit& u) {
    if (g.dil == 1) return (const char*)(g.Bt + (size_t)u.pn * 256 * g.ldb);
    const int b = u.pn >> 3, q = u.pn & 7;
    int tok;
    if (g.dil == 4) tok = b * 2048 + (q & 1) * 256 * 4 + (q >> 1);
    else tok = b * 2048 + 2 * q;
    return (const char*)(g.Bt + (size_t)tok * 1024);
}

struct StaticOrder {
    int nM, nN, nwg, G, c;
    __device__ void init(int nM_, int nN_, int G_, int c_) { nM = nM_; nN = nN_; nwg = nM * nN; G = G_; c = c_; }
    __device__ bool next(int i, Unit& u) const {
        const long L = (long)i * G + c; if (L >= nwg) return false;
        int wgid = (int)L; { const int q = nwg / NXCD, r = nwg % NXCD, xcd = wgid % NXCD, off = wgid / NXCD; wgid = (xcd < r ? xcd * (q + 1) : r * (q + 1) + (xcd - r) * q) + off; }
        const int nig = WGM * nN, gid = wgid / nig, fm = gid * WGM, gsz = (nM - fm) < WGM ? (nM - fm) : WGM;
        u.pm = fm + ((wgid % nig) % gsz); u.pn = (wgid % nig) / gsz; return true;
    }
};

struct RowOrder {
    int nM, nN, nwg, G, c;
    __device__ void init(int nM_, int nN_, int G_, int c_) { nM = nM_; nN = nN_; nwg = nM * nN; G = G_; c = c_; }
    __device__ bool next(int i, Unit& u) const { const int r = i / nN, pn = i - r * nN, pm = c + r * G; if (pm >= nM) return false; u.pm = pm; u.pn = pn; return true; }
};


template <int ACT> struct EpiBf16 {
    static constexpr bool PERM = true;
    bf16* O; size_t ldc;
    __device__ __forceinline__ void operator()(const f32x4 (&acc)[2][2][4][2], const Unit& u, int wr, int wc, int fr, int fq) const {
        const int row0 = u.pm * BM + wr * 64 + fr; const int col0 = u.pn * BM + wc * 32 + 8 * fq;
#pragma unroll
        for (int ai = 0; ai < 2; ++ai)
#pragma unroll
            for (int m = 0; m < 4; ++m) { bf16* rowp = O + (size_t)(row0 + ai * HALF + m * 16) * ldc + col0;
#pragma unroll
                for (int bj = 0; bj < 2; ++bj) { f32x4 v0 = acc[ai][bj][m][0], v1 = acc[ai][bj][m][1];
                    if (ACT == 1) {
#pragma unroll
                        for (int e = 0; e < 4; ++e) { float a = fmaxf(v0[e], 0.f), b = fmaxf(v1[e], 0.f); v0[e] = a * a; v1[e] = b * b; } }
                    u32x4 w; w.x = cvt_pk_bf16(v0[0], v0[1]); w.y = cvt_pk_bf16(v0[2], v0[3]); w.z = cvt_pk_bf16(v1[0], v1[1]); w.w = cvt_pk_bf16(v1[2], v1[3]);
                    *(u32x4*)(rowp + bj * HALF) = w; } }
    }
};

struct EpiYU {
    static constexpr bool PERM = true;
    bf16* GY; bf16* U;
    static __device__ __forceinline__ float gelu_t(float y) {
        const float z2 = 1.5957691216057308f * (y + 0.044715f * y * y * y);
        return y * __builtin_amdgcn_rcpf(1.0f + __builtin_amdgcn_exp2f(-z2 * LOG2E));
    }
    __device__ __forceinline__ void operator()(const f32x4 (&acc)[2][2][4][2], const Unit& u, int wr, int wc, int fr, int fq) const {
        const bool isy = u.pn < 4; bf16* base = isy ? GY : U;
        const int row0 = u.pm * BM + wr * 64 + fr; const int col0 = (u.pn & 3) * BM + wc * 32 + 8 * fq;
#pragma unroll
        for (int ai = 0; ai < 2; ++ai)
#pragma unroll
            for (int m = 0; m < 4; ++m) { bf16* rowp = base + (size_t)(row0 + ai * HALF + m * 16) * 1024 + col0;
#pragma unroll
                for (int bj = 0; bj < 2; ++bj) { f32x4 v0 = acc[ai][bj][m][0], v1 = acc[ai][bj][m][1];
                    asm volatile("" : "+v"(v0), "+v"(v1));
                    if (isy) {
#pragma unroll
                        for (int e = 0; e < 4; ++e) { v0[e] = gelu_t(v0[e]); v1[e] = gelu_t(v1[e]); } }
                    u32x4 w; w.x = cvt_pk_bf16(v0[0], v0[1]); w.y = cvt_pk_bf16(v0[2], v0[3]); w.z = cvt_pk_bf16(v1[0], v1[1]); w.w = cvt_pk_bf16(v1[2], v1[3]);
                    *(u32x4*)(rowp + bj * HALF) = w; }
                asm volatile("" ::: "memory"); }
    }
};

struct EpiQK {
    static constexpr bool PERM = true;
    bf16* O; const float* qg; const float* kg;
    __device__ __forceinline__ void operator()(const f32x4 (&acc)[2][2][4][2], const Unit& u, int wr, int wc, int fr, int fq) const {
        const bool isq = u.pn < 4; const float* gp = isq ? qg : kg; const float mult = isq ? 0.125f * LOG2E : 1.0f;
        const int row0 = u.pm * BM + wr * 64 + fr; const int col0 = u.pn * BM + wc * 64 + 8 * fq;
        f32x4 gv[2][2];
#pragma unroll
        for (int bj = 0; bj < 2; ++bj)
#pragma unroll
            for (int n = 0; n < 2; ++n) gv[bj][n] = *(const f32x4*)(gp + 32 * bj + 8 * fq + 4 * n);
#pragma unroll
        for (int ai = 0; ai < 2; ++ai)
#pragma unroll
            for (int m = 0; m < 4; ++m) {
                float ss = 0.f;
                f32x4 xv[2][2];
#pragma unroll
                for (int bj = 0; bj < 2; ++bj)
#pragma unroll
                    for (int n = 0; n < 2; ++n) xv[bj][n] = acc[ai][bj][m][n];
                asm volatile("" : "+v"(xv[0][0]), "+v"(xv[0][1]), "+v"(xv[1][0]), "+v"(xv[1][1]));
#pragma unroll
                for (int bj = 0; bj < 2; ++bj)
#pragma unroll
                    for (int n = 0; n < 2; ++n) { const f32x4 x = xv[bj][n]; ss += (x[0] * x[0] + x[1] * x[1]) + (x[2] * x[2] + x[3] * x[3]); }
                { const int ln = fq * 16 + fr; ss += shx(ss, 16, ln); ss += shx(ss, 32, ln); }
                const float rs = rsqrtf(ss * (1.0f / 64.0f) + RMS_EPS) * mult;
                bf16* rowp = O + (size_t)(row0 + ai * HALF + m * 16) * 2048 + col0;
#pragma unroll
                for (int bj = 0; bj < 2; ++bj) { const f32x4 v0 = xv[bj][0] * gv[bj][0] * rs, v1 = xv[bj][1] * gv[bj][1] * rs;
                    u32x4 w; w.x = cvt_pk_bf16(v0[0], v0[1]); w.y = cvt_pk_bf16(v0[2], v0[3]); w.z = cvt_pk_bf16(v1[0], v1[1]); w.w = cvt_pk_bf16(v1[2], v1[3]);
                    *(u32x4*)(rowp + bj * 32) = w; }
                asm volatile("" ::: "memory"); }
    }
};

struct EpiGates {
    static constexpr bool PERM = true;
    bf16* GX; bf16* GA;
    __device__ __forceinline__ void operator()(const f32x4 (&acc)[2][2][4][2], const Unit& u, int wr, int wc, int fr, int fq) const {
        const int ch0 = (u.pn >> 1) * 256 + (u.pn & 1) * 128 + wc * 32 + 8 * fq;
        const int row0 = u.pm * BM + wr * 64 + fr;
#pragma unroll
        for (int ai = 0; ai < 2; ++ai)
#pragma unroll
            for (int m = 0; m < 4; ++m) {
                const size_t off = (size_t)(row0 + ai * HALF + m * 16) * 1024 + ch0;
                const f32x4 x0 = acc[ai][0][m][0], x1 = acc[ai][0][m][1], a0 = acc[ai][1][m][0], a1 = acc[ai][1][m][1];
                u32x4 w1, w2;
                w1.x = cvt_pk_bf16(x0[0], x0[1]); w1.y = cvt_pk_bf16(x0[2], x0[3]); w1.z = cvt_pk_bf16(x1[0], x1[1]); w1.w = cvt_pk_bf16(x1[2], x1[3]);
                w2.x = cvt_pk_bf16(a0[0], a0[1]); w2.y = cvt_pk_bf16(a0[2], a0[3]); w2.z = cvt_pk_bf16(a1[0], a1[1]); w2.w = cvt_pk_bf16(a1[2], a1[3]);
                *(u32x4*)(GX + off) = w1; *(u32x4*)(GA + off) = w2;
            }
    }
};

struct EpiResid {
    static constexpr bool PERM = true;
    const float* xin_f32; const bf16* xin_b; float* xout_f32; bf16* xout_b; const float* gate;
    __device__ __forceinline__ void operator()(const f32x4 (&acc)[2][2][4][2], const Unit& u, int wr, int wc, int fr, int fq) const {
        const int col0 = u.pn * BM + wc * 32 + 8 * fq; const int row0 = u.pm * BM + wr * 64 + fr;
        const float* gp = gate + (size_t)(u.pm >> 3) * 6144 + col0;
        f32x4 gv[2][2];
#pragma unroll
        for (int bj = 0; bj < 2; ++bj)
#pragma unroll
            for (int n = 0; n < 2; ++n) gv[bj][n] = *(const f32x4*)(gp + bj * HALF + n * 4);
#pragma unroll
        for (int ai = 0; ai < 2; ++ai)
#pragma unroll
            for (int m = 0; m < 4; ++m) { const size_t off = (size_t)(row0 + ai * HALF + m * 16) * 1024 + col0;
#pragma unroll
                for (int bj = 0; bj < 2; ++bj) {
                    f32x4 x0, x1;
                    if (xin_f32) { x0 = *(const f32x4*)(xin_f32 + off + bj * HALF); x1 = *(const f32x4*)(xin_f32 + off + bj * HALF + 4); }
                    else { const u32x4 w = *(const u32x4*)(xin_b + off + bj * HALF); x0 = (f32x4){bflo(w.x), bfhi(w.x), bflo(w.y), bfhi(w.y)}; x1 = (f32x4){bflo(w.z), bfhi(w.z), bflo(w.w), bfhi(w.w)}; }
                    x0 = x0 + gv[bj][0] * acc[ai][bj][m][0]; x1 = x1 + gv[bj][1] * acc[ai][bj][m][1];
                    if (xout_f32) { *(f32x4*)(xout_f32 + off + bj * HALF) = x0; *(f32x4*)(xout_f32 + off + bj * HALF + 4) = x1; }
                    else { u32x4 w; w.x = cvt_pk_bf16(x0[0], x0[1]); w.y = cvt_pk_bf16(x0[2], x0[3]); w.z = cvt_pk_bf16(x1[0], x1[1]); w.w = cvt_pk_bf16(x1[2], x1[3]); *(u32x4*)(xout_b + off + bj * HALF) = w; }
                } }
    }
};

template <class Epi, class Sched>
__device__ __forceinline__ void gemm_phase(LAS unsigned char* lds, Gemm g, Sched S, const Epi& E) {
    asm volatile("" : "+s"(g.A), "+s"(g.Bt), "+s"(S.c), "+s"(S.G));
    const int tid = opaque_tid(), wid = __builtin_amdgcn_readfirstlane(tid >> 6), lane = tid & 63, wr = wid >> 2, wc = wid & 3, fr = lane & 15, fq = lane >> 4;
    const int K = g.K, nt = K / BK;
    unsigned voffA[2], voffB[2];
#pragma unroll
    for (int i = 0; i < 2; ++i) { int R, C; stage_rc(tid * 16 + i * 8192, R, C); const int Rb = Epi::PERM ? ((R & ~31) + perm32(R & 31)) : R;
        voffA[i] = (unsigned)(R * g.lda + C) * 2u; voffB[i] = (unsigned)(Rb * g.ldb + C) * 2u; }
    const size_t kstep = (size_t)(BK * 2);
    const size_t hstepA = (size_t)HALF * g.lda * 2;
    const size_t hstepB = (g.dil == 16) ? (size_t)2048 : (size_t)HALF * g.ldb * 2;
    const unsigned ldsw = (unsigned)wid * 1024u;
    const int aoff = lds_byte(wr * 64 + fr, fq * 8), boff = lds_byte(wc * 32 + fr, fq * 8);
#define PG8_SA(b, h) (((b) * 2 + (h)) * HTB)
#define PG8_SB(b, h) ((4 + (b) * 2 + (h)) * HTB)
#define PG8_STAGE(bufoff, gbase, voff) do { const char* _gb = (const char*)(gbase); asm("" : "+s"(_gb)); _Pragma("unroll") for (int _i = 0; _i < 2; ++_i) \
        __builtin_amdgcn_global_load_lds((const unsigned*)(_gb + (voff)[_i]), (LAS unsigned*)(lds + (bufoff) + ldsw + _i * 8192), 16, 0, 0); } while (0)
#define PG8_LDA(dst, b, h) do { _Pragma("unroll") for (int m = 0; m < 4; ++m) _Pragma("unroll") for (int k = 0; k < 2; ++k) dst[m][k] = *(const LAS bf16x8*)(lds + PG8_SA(b, h) + aoff + m * 2048 + k * 1024); } while (0)
#define PG8_LDB(dst, b, h) do { _Pragma("unroll") for (int n = 0; n < 2; ++n) _Pragma("unroll") for (int k = 0; k < 2; ++k) dst[n][k] = *(const LAS bf16x8*)(lds + PG8_SB(b, h) + boff + n * 2048 + k * 1024); } while (0)
#define PG8_MMA(ai, bj, At, Bt) do { __builtin_amdgcn_s_setprio(1); _Pragma("unroll") for (int m = 0; m < 4; ++m) _Pragma("unroll") for (int n = 0; n < 2; ++n) _Pragma("unroll") for (int k = 0; k < 2; ++k) \
        acc[ai][bj][m][n] = __builtin_amdgcn_mfma_f32_16x16x32_bf16(Bt[n][k], At[m][k], acc[ai][bj][m][n], 0, 0, 0); __builtin_amdgcn_s_setprio(0); } while (0)
#define PG8_WAIT_V(n) asm volatile("s_waitcnt vmcnt(" #n ")" ::: "memory")
#define PG8_WAIT_L(n) asm volatile("s_waitcnt lgkmcnt(" #n ")" ::: "memory")
#define PG8_BAR __builtin_amdgcn_s_barrier()
#define PG8_SCHED __builtin_amdgcn_sched_barrier(0)
    Unit cur, nxt; int ui = 0;
    if (!S.next(0, cur)) return;
    f32x4 acc[2][2][4][2];
#pragma unroll
    for (int a = 0; a < 2; ++a)
#pragma unroll
        for (int b = 0; b < 2; ++b)
#pragma unroll
            for (int m = 0; m < 4; ++m)
#pragma unroll
                for (int n = 0; n < 2; ++n) acc[a][b][m][n] = (f32x4){0.f, 0.f, 0.f, 0.f};
    bf16x8 At[4][2], B0[2][2], B1[2][2];
    const char* cA = baseA(g, cur); const char* cB = baseB(g, cur);
    PG8_STAGE(PG8_SB(0, 0), cB, voffB); PG8_STAGE(PG8_SB(0, 1), cB + hstepB, voffB); PG8_STAGE(PG8_SA(0, 0), cA, voffA); PG8_STAGE(PG8_SA(0, 1), cA + hstepA, voffA);
    if (wr == 1) PG8_BAR;
    PG8_WAIT_V(2); PG8_BAR;
    PG8_STAGE(PG8_SB(1, 0), cB + kstep, voffB); PG8_STAGE(PG8_SA(1, 0), cA + kstep, voffA); PG8_STAGE(PG8_SB(1, 1), cB + hstepB + kstep, voffB);
    PG8_WAIT_V(6); PG8_BAR;
    for (;;) {
        const bool has_next = S.next(ui + 1, nxt);
        const char* nA = has_next ? baseA(g, nxt) : cA; const char* nB = has_next ? baseB(g, nxt) : cB;
        for (int t = 0; t < nt; t += 2) {
            const bool last = (t == nt - 2);
            const char* a1 = cA + (size_t)(t + 1) * kstep;
            const char* a2 = last ? nA : cA + (size_t)(t + 2) * kstep; const char* b2 = last ? nB : cB + (size_t)(t + 2) * kstep;
            const char* a3 = a2 + kstep; const char* b3 = b2 + kstep;
            PG8_LDB(B0, 0, 0); PG8_LDB(B1, 0, 1); PG8_SCHED; PG8_LDA(At, 0, 0); PG8_STAGE(PG8_SA(1, 1), a1 + hstepA, voffA);
            PG8_WAIT_V(8); PG8_WAIT_L(0); PG8_BAR; PG8_MMA(0, 0, At, B0); PG8_MMA(0, 1, At, B1); PG8_BAR; PG8_SCHED;
            PG8_LDA(At, 0, 1); PG8_STAGE(PG8_SB(0, 0), b2, voffB); PG8_STAGE(PG8_SB(0, 1), b2 + hstepB, voffB); PG8_STAGE(PG8_SA(0, 0), a2, voffA);
            PG8_WAIT_V(8); PG8_WAIT_L(0); PG8_BAR; PG8_MMA(1, 0, At, B0); PG8_MMA(1, 1, At, B1); PG8_BAR; PG8_SCHED;
            PG8_LDB(B0, 1, 0); PG8_LDB(B1, 1, 1); PG8_SCHED; PG8_LDA(At, 1, 0); PG8_STAGE(PG8_SA(0, 1), a2 + hstepA, voffA);
            PG8_WAIT_V(8); PG8_WAIT_L(0); PG8_BAR; PG8_MMA(0, 0, At, B0); PG8_MMA(0, 1, At, B1); PG8_BAR; PG8_SCHED;
            PG8_LDA(At, 1, 1); PG8_STAGE(PG8_SB(1, 0), b3, voffB); PG8_STAGE(PG8_SB(1, 1), b3 + hstepB, voffB); PG8_STAGE(PG8_SA(1, 0), a3, voffA);
            PG8_WAIT_V(8); PG8_WAIT_L(0); PG8_BAR; PG8_MMA(1, 0, At, B0); PG8_MMA(1, 1, At, B1); PG8_BAR; PG8_SCHED;
        }
        if (wr == 0) PG8_BAR;
        { const int te = opaque_tid(), we = __builtin_amdgcn_readfirstlane(te >> 6), le = te & 63;
          E(acc, cur, we >> 2, we & 3, le & 15, le >> 4); }
        if (!has_next) break;
#pragma unroll
        for (int a = 0; a < 2; ++a)
#pragma unroll
            for (int b = 0; b < 2; ++b)
#pragma unroll
                for (int m = 0; m < 4; ++m)
#pragma unroll
                    for (int n = 0; n < 2; ++n) acc[a][b][m][n] = (f32x4){0.f, 0.f, 0.f, 0.f};
        cur = nxt; cA = nA; cB = nB; ++ui;
        if (wr == 1) PG8_BAR;
    }
    PG8_WAIT_V(0);
    PG8_BAR;
#undef PG8_SA
#undef PG8_SB
#undef PG8_STAGE
#undef PG8_LDA
#undef PG8_LDB
#undef PG8_MMA
#undef PG8_WAIT_V
#undef PG8_WAIT_L
#undef PG8_BAR
#undef PG8_SCHED
}
}

constexpr int AT_KROW = 272, AT_VROW = 136, AT_KBYTES = 64 * AT_KROW, AT_VBYTES = 128 * AT_VROW, AT_BUF = AT_KBYTES + AT_VBYTES;
constexpr int AT_BIAS_OFF = 2 * AT_BUF;
template <int MODE>
__device__ __forceinline__ void attn_unit(LAS unsigned char* lds, const bf16* QK, const bf16* Vt, const float* biasT,
                                          int b, int hp, int c, int dil, int jblk, bf16* AO, float* LSE, int gidx,
                                          float lam, const float* subgain, float one_m_li, bool load_bias) {
    constexpr int NDV = (MODE == 0) ? 4 : 2;
    const int tid = opaque_tid(), lane = tid & 63, wid = __builtin_amdgcn_readfirstlane(tid >> 6);
    const int mp = wid >> 2, wq = wid & 3, r32 = lane & 31, hi = lane >> 5;
    const int L = SEQ / dil;
    const size_t tok0 = (size_t)b * SEQ + c;
    const size_t vcol0 = (size_t)b * SEQ + (size_t)c * L;
    LAS float* biasL = (LAS float*)(lds + AT_BIAS_OFF);
    if (load_bias) {
        const int nb = (MODE == 0) ? 2048 : 129;
        for (int i = tid; i < 2 * nb; i += NT_) { const int mm = i / nb, ii = i - mm * nb; biasL[mm * 2048 + ii] = biasT[(size_t)(2 * hp + mm) * 2048 + min(ii * dil, 2047)]; }
    }
    const int q_lo = 128 * jblk + 32 * wq;
    const int qi = q_lo + r32;
    const size_t qtok = tok0 + (size_t)qi * dil;
    bf16x8 qf[4];
#pragma unroll
    for (int ds = 0; ds < 4; ++ds) qf[ds] = *(const GAS bf16x8*)(QK + qtok * 2048 + (2 * hp + mp) * 64 + 16 * ds + 8 * hi);
    const int kt_hi = 2 * jblk + 1;
    const int kt_lo = (MODE == 0) ? 0 : ((jblk > 0) ? 2 * jblk - 2 : 0);
    const int kp_row0 = tid >> 4, kp_c = tid & 15;
    const int vp_row0 = tid >> 3, vp_c = tid & 7;
    const bf16* ksrc = QK + 1024 + 2 * hp * 64 + kp_c * 8;
    const bf16* vsrc = Vt + (size_t)(2 * hp * 64 + vp_row0) * TOK + vcol0 + vp_c * 8;
    u32x4 kr0, kr1, vr0, vr1;
    {
        const int kv0 = 64 * kt_lo;
        kr0 = *(const GAS u32x4*)(ksrc + (tok0 + (size_t)(kv0 + kp_row0) * dil) * 2048);
        kr1 = *(const GAS u32x4*)(ksrc + (tok0 + (size_t)(kv0 + kp_row0 + 32) * dil) * 2048);
        vr0 = *(const GAS u32x4*)(vsrc + kv0);
        vr1 = *(const GAS u32x4*)(vsrc + (size_t)64 * TOK + kv0);
        LAS unsigned char* kb = lds; LAS unsigned char* vb = lds + AT_KBYTES;
        *(LAS u32x4*)(kb + kp_row0 * AT_KROW + kp_c * 16) = kr0; *(LAS u32x4*)(kb + (kp_row0 + 32) * AT_KROW + kp_c * 16) = kr1;
        { LAS unsigned char* p0 = vb + vp_row0 * AT_VROW + vp_c * 16; LAS unsigned char* p1 = vb + (vp_row0 + 64) * AT_VROW + vp_c * 16;
          *(LAS u32x2*)p0 = (u32x2){vr0.x, vr0.y}; *(LAS u32x2*)(p0 + 8) = (u32x2){vr0.z, vr0.w}; *(LAS u32x2*)p1 = (u32x2){vr1.x, vr1.y}; *(LAS u32x2*)(p1 + 8) = (u32x2){vr1.z, vr1.w}; }
    }
    f32x16 acc[NDV];
#pragma unroll
    for (int i = 0; i < NDV; ++i)
#pragma unroll
        for (int r = 0; r < 16; ++r) acc[i][r] = 0.f;
    float mrun = -1e30f, lsum = 0.f;
    float la_pre = 0.f; u32x2 pw_pre[NDV][4];
    if (MODE == 1 && gidx > 0) {
        la_pre = *(const GAS float*)(LSE + qtok * 16 + 2 * hp + mp);
#pragma unroll
        for (int dvb = 0; dvb < NDV; ++dvb)
#pragma unroll
            for (int g4 = 0; g4 < 4; ++g4) pw_pre[dvb][g4] = *(const GAS u32x2*)(AO + qtok * 1024 + (2 * hp + mp) * 64 + 32 * dvb + 8 * g4 + 4 * hi);
    }
    const int dvoff = (MODE == 0) ? 0 : 64 * mp;
    for (int kt = kt_lo; kt <= kt_hi; ++kt) {
        const int bufsel = (kt - kt_lo) & 1;
        __syncthreads();
        const bool more = kt < kt_hi;
        if (more) {
            const int kv1 = 64 * (kt + 1);
            kr0 = *(const GAS u32x4*)(ksrc + (tok0 + (size_t)(kv1 + kp_row0) * dil) * 2048);
            kr1 = *(const GAS u32x4*)(ksrc + (tok0 + (size_t)(kv1 + kp_row0 + 32) * dil) * 2048);
            vr0 = *(const GAS u32x4*)(vsrc + kv1);
            vr1 = *(const GAS u32x4*)(vsrc + (size_t)64 * TOK + kv1);
            asm volatile("" ::: "memory");
        }
        const int kv0 = 64 * kt;
        bool skip = kv0 > q_lo + 31;
        if (MODE == 1) skip = skip || (kv0 + 63 < q_lo - 128);
        if (!skip) {
            const LAS unsigned char* kb = lds + bufsel * AT_BUF; const LAS unsigned char* vb = kb + AT_KBYTES;
            f32x16 s0, s1;
#pragma unroll
            for (int r = 0; r < 16; ++r) { s0[r] = 0.f; s1[r] = 0.f; }
            {
                bf16x8 ka[4], kc[4];
#pragma unroll
                for (int ds = 0; ds < 4; ++ds) {
                    ka[ds] = *(const LAS bf16x8*)(kb + r32 * AT_KROW + mp * 128 + (16 * ds + 8 * hi) * 2);
                    kc[ds] = *(const LAS bf16x8*)(kb + (32 + r32) * AT_KROW + mp * 128 + (16 * ds + 8 * hi) * 2);
                }
                __builtin_amdgcn_sched_barrier(0);
#pragma unroll
                for (int ds = 0; ds < 4; ++ds) {
                    s0 = __builtin_amdgcn_mfma_f32_32x32x16_bf16(ka[ds], qf[ds], s0, 0, 0, 0);
                    s1 = __builtin_amdgcn_mfma_f32_32x32x16_bf16(kc[ds], qf[ds], s1, 0, 0, 0);
                }
            }
            const int relbase = qi - kv0 - 4 * hi;
            constexpr int cmax = (MODE == 0) ? 2047 : 128;
            float mx = -1e30f;
            bool interior = (kv0 + 63 <= q_lo);
            if (MODE == 1) interior = interior && (q_lo + 31 - kv0 <= 128);
            if (interior) {
                const LAS float* p = biasL + mp * 2048 + (relbase - 59);
#pragma unroll
                for (int r = 0; r < 16; ++r) {
                    const int o = 59 - ((r & 3) + 8 * (r >> 2));
                    s0[r] += p[o]; s1[r] += p[o - 32];
                    mx = fmaxf(mx, fmaxf(s0[r], s1[r]));
                }
            } else {
                const volatile LAS float* bl = (const volatile LAS float*)(biasL + mp * 2048);
                float bb0[16], bb1[16];
#pragma unroll
                for (int r = 0; r < 16; ++r) {
                    const int rel0 = relbase - ((r & 3) + 8 * (r >> 2));
                    bb0[r] = bl[min(max(rel0, 0), cmax)]; bb1[r] = bl[min(max(rel0 - 32, 0), cmax)];
                }
#pragma unroll
                for (int r = 0; r < 16; ++r) {
                    const int rel0 = relbase - ((r & 3) + 8 * (r >> 2)), rel1 = rel0 - 32;
                    bool ok0 = rel0 >= 0, ok1 = rel1 >= 0;
                    if (MODE == 1) { ok0 = ok0 && (rel0 <= 128); ok1 = ok1 && (rel1 <= 128); }
                    const float t0 = s0[r] + bb0[r], t1 = s1[r] + bb1[r];
                    s0[r] = ok0 ? t0 : -1e30f; s1[r] = ok1 ? t1 : -1e30f;
                    mx = fmaxf(mx, fmaxf(s0[r], s1[r]));
                }
            }
            mx = max_x32(mx);
            const float mnew = fmaxf(mrun, mx);
            const float alpha = fast_exp2(mrun - mnew);
            mrun = mnew;
            float ps = 0.f;
#pragma unroll
            for (int r = 0; r < 16; ++r) { s0[r] = fast_exp2(s0[r] - mnew); s1[r] = fast_exp2(s1[r] - mnew); ps += s0[r] + s1[r]; }
            lsum = lsum * alpha + ps;
#pragma unroll
            for (int i = 0; i < NDV; ++i)
#pragma unroll
                for (int r = 0; r < 16; ++r) acc[i][r] *= alpha;
            bf16x8 pf[2][2];
#pragma unroll
            for (int t = 0; t < 2; ++t) {
                u32x4 w0, w1;
                w0.x = cvt_pk_bf16(s0[8 * t + 0], s0[8 * t + 1]); w0.y = cvt_pk_bf16(s0[8 * t + 2], s0[8 * t + 3]); w0.z = cvt_pk_bf16(s0[8 * t + 4], s0[8 * t + 5]); w0.w = cvt_pk_bf16(s0[8 * t + 6], s0[8 * t + 7]);
                w1.x = cvt_pk_bf16(s1[8 * t + 0], s1[8 * t + 1]); w1.y = cvt_pk_bf16(s1[8 * t + 2], s1[8 * t + 3]); w1.z = cvt_pk_bf16(s1[8 * t + 4], s1[8 * t + 5]); w1.w = cvt_pk_bf16(s1[8 * t + 6], s1[8 * t + 7]);
                pf[0][t] = __builtin_bit_cast(bf16x8, w0); pf[1][t] = __builtin_bit_cast(bf16x8, w1);
            }
#define AT_LOADV(dst, dvb_) do { const LAS unsigned char* vrow_ = vb + (dvoff + 32 * (dvb_) + r32) * AT_VROW + 8 * hi; \
                _Pragma("unroll") for (int i_ = 0; i_ < 4; ++i_) { const s16x4 lo4_ = *(const LAS s16x4*)(vrow_ + (16 * i_) * 2), hi4_ = *(const LAS s16x4*)(vrow_ + (16 * i_ + 8) * 2); \
                    dst[i_] = (bf16x8){lo4_[0], lo4_[1], lo4_[2], lo4_[3], hi4_[0], hi4_[1], hi4_[2], hi4_[3]}; } } while (0)
            {
                bf16x8 vcur[4], vnxt[4];
                AT_LOADV(vcur, 0);
#pragma unroll
                for (int dvb = 0; dvb < NDV; ++dvb) {
                    if (dvb + 1 < NDV) AT_LOADV(vnxt, dvb + 1);
                    __builtin_amdgcn_sched_barrier(0);
#pragma unroll
                    for (int i = 0; i < 4; ++i) acc[dvb] = __builtin_amdgcn_mfma_f32_32x32x16_bf16(vcur[i], pf[i >> 1][i & 1], acc[dvb], 0, 0, 0);
                    __builtin_amdgcn_sched_barrier(0);
#pragma unroll
                    for (int i = 0; i < 4; ++i) vcur[i] = vnxt[i];
                }
            }
#undef AT_LOADV
        }
        if (more) {
            LAS unsigned char* kb = lds + (bufsel ^ 1) * AT_BUF; LAS unsigned char* vb = kb + AT_KBYTES;
            *(LAS u32x4*)(kb + kp_row0 * AT_KROW + kp_c * 16) = kr0; *(LAS u32x4*)(kb + (kp_row0 + 32) * AT_KROW + kp_c * 16) = kr1;
            { LAS unsigned char* p0 = vb + vp_row0 * AT_VROW + vp_c * 16; LAS unsigned char* p1 = vb + (vp_row0 + 64) * AT_VROW + vp_c * 16;
          *(LAS u32x2*)p0 = (u32x2){vr0.x, vr0.y}; *(LAS u32x2*)(p0 + 8) = (u32x2){vr0.z, vr0.w}; *(LAS u32x2*)p1 = (u32x2){vr1.x, vr1.y}; *(LAS u32x2*)(p1 + 8) = (u32x2){vr1.z, vr1.w}; }
        }
    }
    const float ltot = sum_x32(lsum);
    const float inv = 1.0f / ltot;
    if (MODE == 0) {
        LAS float* xch = (LAS float*)lds;
        f32x4 sgv[NDV][4];
        if (mp == 0) {
#pragma unroll
            for (int dvb = 0; dvb < NDV; ++dvb)
#pragma unroll
                for (int g4 = 0; g4 < 4; ++g4) sgv[dvb][g4] = *(const GAS f32x4*)(subgain + 32 * dvb + 8 * g4 + 4 * hi);
        }
        __syncthreads();
        if (mp == 1) {
#pragma unroll
            for (int dvb = 0; dvb < NDV; ++dvb)
#pragma unroll
                for (int r = 0; r < 16; ++r) { const int dv = 32 * dvb + (r & 3) + 8 * (r >> 2) + 4 * hi; xch[(wq * 128 + dv) * 32 + r32] = acc[dvb][r] * inv; }
        }
        __syncthreads();
        if (mp == 0) {
            float ss = 0.f;
#pragma unroll
            for (int dvb = 0; dvb < NDV; ++dvb)
#pragma unroll
                for (int r = 0; r < 16; ++r) { const int dv = 32 * dvb + (r & 3) + 8 * (r >> 2) + 4 * hi; const float o = acc[dvb][r] * inv - lam * xch[(wq * 128 + dv) * 32 + r32]; acc[dvb][r] = o; ss += o * o; }
            ss += shx(ss, 32, lane);
            const float rs = rsqrtf(ss * (1.0f / 128.0f) + RMS_EPS) * one_m_li;
            bf16* orow = AO + qtok * 1024 + hp * 128;
#pragma unroll
            for (int dvb = 0; dvb < NDV; ++dvb)
#pragma unroll
                for (int g4 = 0; g4 < 4; ++g4) { const int dv0 = 32 * dvb + 8 * g4 + 4 * hi; const f32x4 sg = sgv[dvb][g4];
                    u32x2 w; w.x = cvt_pk_bf16(acc[dvb][4 * g4 + 0] * rs * sg[0], acc[dvb][4 * g4 + 1] * rs * sg[1]); w.y = cvt_pk_bf16(acc[dvb][4 * g4 + 2] * rs * sg[2], acc[dvb][4 * g4 + 3] * rs * sg[3]);
                    *(u32x2*)(orow + dv0) = w; }
        }
        __syncthreads();
    } else {
        const int head = 2 * hp + mp;
        const float lse2 = mrun + __log2f(ltot);
        float wa = 0.f, wg = 1.f, lsen = lse2;
        if (gidx > 0) {
            const float la = la_pre; const float mxl = fmaxf(la, lse2);
            const float ea = fast_exp2(la - mxl), eg = fast_exp2(lse2 - mxl), tot = ea + eg;
            wa = ea / tot; wg = eg / tot; lsen = mxl + __log2f(tot);
        }
        const float sc = inv * wg;
        bf16* orow = AO + qtok * 1024 + head * 64;
#pragma unroll
        for (int dvb = 0; dvb < NDV; ++dvb)
#pragma unroll
            for (int g4 = 0; g4 < 4; ++g4) { const int dv0 = 32 * dvb + 8 * g4 + 4 * hi;
                float o0 = acc[dvb][4 * g4 + 0] * sc, o1 = acc[dvb][4 * g4 + 1] * sc, o2 = acc[dvb][4 * g4 + 2] * sc, o3 = acc[dvb][4 * g4 + 3] * sc;
                if (gidx > 0) { const u32x2 pw = pw_pre[dvb][g4]; o0 += wa * bflo(pw.x); o1 += wa * bfhi(pw.x); o2 += wa * bflo(pw.y); o3 += wa * bfhi(pw.y); }
                u32x2 w; w.x = cvt_pk_bf16(o0, o1); w.y = cvt_pk_bf16(o2, o3);
                *(u32x2*)(orow + dv0) = w; }
        if (hi == 0 && gidx < 2) LSE[qtok * 16 + head] = lsen;
        __syncthreads();
    }
}

#define XB_TMO      128
#define XB_XCNT(j)  (256  + 64 * (j))
#define XB_XSUB(j)  (1280 + 64 * (j))
#define XB_XGEN(j)  (2304 + 64 * (j))
#define XB_TOP      3328
#define XB_TOPGEN   3392
#define XCD_BAR_WORDS 3456
#define XB_SPIN_CAP (1u << 18)

__device__ __forceinline__ unsigned xb_ld(unsigned* p)              { return __hip_atomic_load(p, __ATOMIC_RELAXED, __HIP_MEMORY_SCOPE_AGENT); }
__device__ __forceinline__ unsigned xb_add(unsigned* p, unsigned v) { return __hip_atomic_fetch_add(p, v, __ATOMIC_RELAXED, __HIP_MEMORY_SCOPE_AGENT); }
__device__ __forceinline__ unsigned xb_xcc_id() { return (unsigned)__builtin_amdgcn_s_getreg((3 << 11) | 20) & 0xFu; }
#define XB_SPIN(cond, bar) do { unsigned _sp = 0; while (cond) { __builtin_amdgcn_s_sleep(1); \
    if ((++_sp & 255u) == 0u) { if (xb_ld(&(bar)[XB_TMO])) break; if (_sp > XB_SPIN_CAP) { atomicAdd(&(bar)[XB_TMO], 1u); break; } } } } while (0)

struct XcdBarrier {
    unsigned* bar; unsigned x;
    volatile LAS unsigned* st;
};

__device__ __forceinline__ XcdBarrier xcd_barrier_post(unsigned* bar, volatile LAS unsigned* st) {
    XcdBarrier b; b.bar = bar; b.x = xb_xcc_id(); b.st = st;
    if (threadIdx.x == 0) (void)xb_add(&bar[XB_XCNT(b.x)], 1u);
    return b;
}
__device__ __forceinline__ void xcd_barrier_complete(unsigned* bar, unsigned x, unsigned& nloc, unsigned& nx) {
    const unsigned G = gridDim.x * gridDim.y * gridDim.z;
    unsigned sum, cnt, mine, sp = 0u;
    for (;;) {
        sum = 0u; cnt = 0u; mine = 0u;
#pragma unroll
        for (unsigned j = 0; j < 16; ++j) { const unsigned c = xb_ld(&bar[XB_XCNT(j)]); sum += c; cnt += (c > 0u) ? 1u : 0u; mine = (j == x) ? c : mine; }
        if (sum == G) break;
        __builtin_amdgcn_s_sleep(1);
        if ((++sp & 255u) == 0u) { if (xb_ld(&bar[XB_TMO])) break; if (sp > XB_SPIN_CAP) { atomicAdd(&bar[XB_TMO], 1u); break; } }
    }
    nloc = mine > 0u ? mine : 1u; nx = cnt > 0u ? cnt : 1u;
}

__device__ __forceinline__ void xcd_barrier(const XcdBarrier& b) {
    asm volatile("s_waitcnt vmcnt(0)" ::: "memory");
    __syncthreads();
    if (threadIdx.x == 0) {
        unsigned* bar = b.bar;
        __builtin_amdgcn_s_waitcnt(0);
        unsigned nloc = b.st[0], nx = b.st[1];
        if (nloc == 0u) { xcd_barrier_complete(bar, b.x, nloc, nx); b.st[0] = nloc; b.st[1] = nx; }
        const unsigned old = xb_add(&bar[XB_XSUB(b.x)], 1u);
        const unsigned gen = old / nloc;
        if (old + 1u == (gen + 1u) * nloc) {
            __builtin_amdgcn_fence(__ATOMIC_RELEASE, "agent");
            asm volatile("s_waitcnt vmcnt(0)" ::: "memory");
            const unsigned og = xb_add(&bar[XB_TOP], 1u);
            const unsigned tg = og / nx;
            if (og + 1u == (tg + 1u) * nx) xb_add(&bar[XB_TOPGEN], 1u);
            else XB_SPIN(xb_ld(&bar[XB_TOPGEN]) == tg, bar);
            __builtin_amdgcn_fence(__ATOMIC_ACQUIRE, "agent");
            xb_add(&bar[XB_XGEN(b.x)], 1u);
            asm volatile("s_waitcnt vmcnt(0)" ::: "memory");
        } else {
            XB_SPIN(xb_ld(&bar[XB_XGEN(b.x)]) == gen, bar);
            __builtin_amdgcn_fence(__ATOMIC_ACQUIRE, "agent");
            asm volatile("s_waitcnt vmcnt(0)" ::: "memory");
        }
    }
    __syncthreads();
}

struct Args { const float* in[31]; float* out; unsigned char* ws; };


__device__ __forceinline__ void transpose_item(const float* W, int ldw, int K, int nblk, bf16* WT, int mode, int row_off, LAS float* scr, int item, int lane) {
    const int kb = item / nblk, nb = item - kb * nblk, k0 = 64 * kb, n0 = 32 * nb;
#pragma unroll 8
    for (int i = 0; i < 32; ++i) { const int kk = 2 * i + (lane >> 5); scr[kk * 33 + (lane & 31)] = W[(size_t)(k0 + kk) * ldw + n0 + (lane & 31)]; }
    asm volatile("s_waitcnt lgkmcnt(0)" ::: "memory");
    int drow;
    if (mode == 0) drow = n0;
    else if (mode == 1) { const int tile = n0 >> 8, ac = n0 & 255, wc = ac >> 6, bj = (ac >> 5) & 1; drow = 256 * tile + 128 * bj + 32 * wc; }
    else drow = 256 * (n0 >> 7) + (n0 & 127);
    drow += row_off;
    const int c = lane & 7;
#pragma unroll
    for (int j = 0; j < 4; ++j) { const int n = (lane >> 3) + 8 * j; const LAS float* s = scr + (8 * c) * 33 + n;
        u32x4 o; o.x = cvt_pk_bf16(s[0 * 33], s[1 * 33]); o.y = cvt_pk_bf16(s[2 * 33], s[3 * 33]); o.z = cvt_pk_bf16(s[4 * 33], s[5 * 33]); o.w = cvt_pk_bf16(s[6 * 33], s[7 * 33]);
        *(u32x4*)(WT + (size_t)(drow + n) * K + k0 + 8 * c) = o; }
    asm volatile("s_waitcnt lgkmcnt(0)" ::: "memory");
}

__device__ __forceinline__ int t5_bucket(int n) {
    if (n < 16) return n;
    const float nf = (float)n;
    int v = 16 + (int)(logf(nf / 16.0f) / 4.852030263919617f * 16.0f);
    return v < 31 ? v : 31;
}

__device__ __forceinline__ void norm_phase(const float* x, const float* gain, const float* shift, const float* scale, bf16* H, int bid, int ngw) {
    const int tid = opaque_tid(), lane = tid & 63, gw = bid * 8 + __builtin_amdgcn_readfirstlane(tid >> 6);
    f32x4 gv[4];
#pragma unroll
    for (int j = 0; j < 4; ++j) gv[j] = *(const f32x4*)(gain + 4 * lane + 256 * j);
    for (int row = gw; row < TOK; row += ngw) {
        const f32x4* xr = (const f32x4*)(x + (size_t)row * 1024) + lane;
        const int b = row >> 11;
        f32x4 v[4]; float s = 0.f;
#pragma unroll
        for (int j = 0; j < 4; ++j) { v[j] = xr[64 * j]; s += (v[j].x * v[j].x + v[j].y * v[j].y) + (v[j].z * v[j].z + v[j].w * v[j].w); }
        const float rstd = rsqrtf(wave_sum(s, lane) * (1.0f / 1024.0f) + RMS_EPS);
        unsigned long long* o8 = (unsigned long long*)(H + (size_t)row * 1024) + lane;
#pragma unroll
        for (int j = 0; j < 4; ++j) {
            const f32x4 sc = *(const f32x4*)(scale + (size_t)b * 6144 + 4 * lane + 256 * j), sh = *(const f32x4*)(shift + (size_t)b * 6144 + 4 * lane + 256 * j);
            const f32x4 y = v[j] * rstd * gv[j] * (sc + 1.0f) + sh;
            o8[64 * j] = (unsigned long long)cvt_pk_bf16(y.x, y.y) | ((unsigned long long)cvt_pk_bf16(y.z, y.w) << 32);
        }
    }
}

__device__ __forceinline__ void lru_coef(const u32x4 xw, const u32x4 aw, const u32x4 uw, const float (&sp)[8], const float (&bxv)[8], const float (&bav)[8], float (&l8)[8], float (&b8)[8]) {
    const float gx[8] = {bflo(xw.x), bfhi(xw.x), bflo(xw.y), bfhi(xw.y), bflo(xw.z), bfhi(xw.z), bflo(xw.w), bfhi(xw.w)};
    const float ga[8] = {bflo(aw.x), bfhi(aw.x), bflo(aw.y), bfhi(aw.y), bflo(aw.z), bfhi(aw.z), bflo(aw.w), bfhi(aw.w)};
    const float uu[8] = {bflo(uw.x), bfhi(uw.x), bflo(uw.y), bfhi(uw.y), bflo(uw.z), bfhi(uw.z), bflo(uw.w), bfhi(uw.w)};
#pragma unroll
    for (int j = 0; j < 8; ++j) {
        const float sx = __builtin_amdgcn_rcpf(1.0f + __builtin_amdgcn_exp2f(-(gx[j] + bxv[j]) * LOG2E));
        const float sa = __builtin_amdgcn_rcpf(1.0f + __builtin_amdgcn_exp2f(-(ga[j] + bav[j]) * LOG2E));
        const float la = sa * sp[j];
        const float x2 = 2.0f * la;
        const float om = (x2 > -0.02f) ? -x2 * (1.0f + x2 * (0.5f + x2 * 0.16666667f)) : 1.0f - __builtin_amdgcn_exp2f(x2 * LOG2E);
        l8[j] = la * LOG2E; b8[j] = __builtin_amdgcn_sqrtf(fmaxf(om, 0.f)) * sx * uu[j];
    }
}

__device__ __forceinline__ void norm_row_b(const bf16* xrow, bf16* hrow, const f32x4 (&gv)[2][2], const f32x4 (&scv)[2][2], const f32x4 (&shv)[2][2], int lane) {
    f32x4 v[2][2]; float s = 0.f;
#pragma unroll
    for (int j = 0; j < 2; ++j) { const u32x4 w = *(const u32x4*)(xrow + 8 * lane + 512 * j);
        v[j][0] = (f32x4){bflo(w.x), bfhi(w.x), bflo(w.y), bfhi(w.y)}; v[j][1] = (f32x4){bflo(w.z), bfhi(w.z), bflo(w.w), bfhi(w.w)};
#pragma unroll
        for (int n = 0; n < 2; ++n) s += (v[j][n].x * v[j][n].x + v[j][n].y * v[j][n].y) + (v[j][n].z * v[j][n].z + v[j][n].w * v[j][n].w); }
    const float rstd = rsqrtf(wave_sum(s, lane) * (1.0f / 1024.0f) + RMS_EPS);
#pragma unroll
    for (int j = 0; j < 2; ++j) { const f32x4 y0 = v[j][0] * rstd * gv[j][0] * scv[j][0] + shv[j][0], y1 = v[j][1] * rstd * gv[j][1] * scv[j][1] + shv[j][1];
        u32x4 w; w.x = cvt_pk_bf16(y0.x, y0.y); w.y = cvt_pk_bf16(y0.z, y0.w); w.z = cvt_pk_bf16(y1.x, y1.y); w.w = cvt_pk_bf16(y1.z, y1.w);
        *(u32x4*)(hrow + 8 * lane + 512 * j) = w; }
}
template <int R>
__device__ __forceinline__ void norm_rows_b(const bf16* xrow, bf16* hrow, const f32x4 (&gv)[2][2], const f32x4 (&scv)[2][2], const f32x4 (&shv)[2][2], int lane) {
    u32x4 w[R][2];
#pragma unroll
    for (int q = 0; q < R; ++q)
#pragma unroll
        for (int j = 0; j < 2; ++j) w[q][j] = *(const u32x4*)(xrow + (size_t)q * 1024 + 8 * lane + 512 * j);
    f32x4 v[R][2][2]; float ssq[R];
#pragma unroll
    for (int q = 0; q < R; ++q) { float s_ = 0.f;
#pragma unroll
        for (int j = 0; j < 2; ++j) { const u32x4 ww = w[q][j];
            v[q][j][0] = (f32x4){bflo(ww.x), bfhi(ww.x), bflo(ww.y), bfhi(ww.y)}; v[q][j][1] = (f32x4){bflo(ww.z), bfhi(ww.z), bflo(ww.w), bfhi(ww.w)};
#pragma unroll
            for (int n = 0; n < 2; ++n) s_ += (v[q][j][n].x * v[q][j][n].x + v[q][j][n].y * v[q][j][n].y) + (v[q][j][n].z * v[q][j][n].z + v[q][j][n].w * v[q][j][n].w); }
        ssq[q] = s_; }
#pragma unroll
    for (int o = 1; o < 64; o <<= 1)
#pragma unroll
        for (int q = 0; q < R; ++q) ssq[q] += shx(ssq[q], o, lane);
#pragma unroll
    for (int q = 0; q < R; ++q) { const float rstd = rsqrtf(ssq[q] * (1.0f / 1024.0f) + RMS_EPS);
#pragma unroll
        for (int j = 0; j < 2; ++j) { const f32x4 y0 = v[q][j][0] * rstd * gv[j][0] * scv[j][0] + shv[j][0], y1 = v[q][j][1] * rstd * gv[j][1] * scv[j][1] + shv[j][1];
            u32x4 o_; o_.x = cvt_pk_bf16(y0.x, y0.y); o_.y = cvt_pk_bf16(y0.z, y0.w); o_.z = cvt_pk_bf16(y1.x, y1.y); o_.w = cvt_pk_bf16(y1.z, y1.w);
            *(u32x4*)(hrow + (size_t)q * 1024 + 8 * lane + 512 * j) = o_; } }
}
#define NORM_B_LOAD_GAIN(gain) f32x4 gv[2][2]; _Pragma("unroll") for (int j = 0; j < 2; ++j) _Pragma("unroll") for (int n = 0; n < 2; ++n) gv[j][n] = *(const f32x4*)((gain) + 8 * lane + 512 * j + 4 * n);
#define NORM_B_LOAD_MOD(b) f32x4 scv[2][2], shv[2][2]; _Pragma("unroll") for (int j = 0; j < 2; ++j) _Pragma("unroll") for (int n = 0; n < 2; ++n) { \
        scv[j][n] = *(const f32x4*)(scale + (size_t)(b) * 6144 + 8 * lane + 512 * j + 4 * n) + 1.0f; shv[j][n] = *(const f32x4*)(shift + (size_t)(b) * 6144 + 8 * lane + 512 * j + 4 * n); }
__device__ __forceinline__ void norm_phase_b(const bf16* xb, const float* gain, const float* shift, const float* scale, bf16* H, int bid, int ngw) {
    const int tid = opaque_tid(), lane = tid & 63, gw = bid * 8 + __builtin_amdgcn_readfirstlane(tid >> 6);
    NORM_B_LOAD_GAIN(gain)
    for (int slab = gw; slab < TOK / 32; slab += ngw) {
        const int row0 = slab * 32;
        NORM_B_LOAD_MOD(row0 >> 11)
        for (int r = 0; r < 32; r += 4) norm_rows_b<4>(xb + (size_t)(row0 + r) * 1024, H + (size_t)(row0 + r) * 1024, gv, scv, shv, lane);
    }
}

__device__ __forceinline__ void norm_panels(const bf16* xb, const float* gain, const float* shift, const float* scale, bf16* H, int bid, int G) {
    const int tid = opaque_tid(), lane = tid & 63, wave = __builtin_amdgcn_readfirstlane(tid >> 6);
    NORM_B_LOAD_GAIN(gain)
    for (int pm = bid; pm < 256; pm += G) {
        NORM_B_LOAD_MOD(pm >> 3)
        const int row0 = pm * 256 + wave * 32;
        for (int r = 0; r < 32; r += 4) norm_rows_b<4>(xb + (size_t)(row0 + r) * 1024, H + (size_t)(row0 + r) * 1024, gv, scv, shv, lane);
    }
}

__global__ void __launch_bounds__(NT_, 2) fwd_mega(Args args) {
    extern __shared__ __attribute__((aligned(16))) unsigned char lds_raw[];
    LAS unsigned char* lds = (LAS unsigned char*)lds_raw;
    cg::grid_group grid = cg::this_grid();
#define GSYNC_HIP() do { asm volatile("s_waitcnt vmcnt(0) lgkmcnt(0)" ::: "memory"); grid.sync(); } while (0)
#define GSYNC() do { XcdBarrier xb_; xb_.bar = (unsigned*)(ws + WS_BAR); xb_.x = xb_xcc_id(); xb_.st = (volatile LAS unsigned*)(lds + LDS_XB_OFF); xcd_barrier(xb_); } while (0)
    const int G = gridDim.x, bid = blockIdx.x;
    if (threadIdx.x < 4) ((LAS unsigned*)(lds + LDS_XB_OFF))[threadIdx.x] = 0u;
    __syncthreads();
    (void)xcd_barrier_post((unsigned*)(args.ws + WS_BAR), (volatile LAS unsigned*)(lds + LDS_XB_OFF));
    const int ngw = G * 8, ngt = G * NT_;
#define PHASE_IDS const int tid = opaque_tid(), lane = tid & 63, wave = __builtin_amdgcn_readfirstlane(tid >> 6), gw = bid * 8 + wave, gtid = bid * NT_ + tid; (void)lane; (void)wave; (void)gw; (void)gtid;
    unsigned char* ws = args.ws;
    const float* x_in = args.in[0]; float* xo = args.out;
#define scal ((float*)(ws + WS_SCAL))
#define mod ((float*)(ws + WS_MOD))
#define biasT ((float*)(ws + WS_BIAS))
#define CS ((float*)(ws + WS_CS))
#define CH ((float*)(ws + WS_CH))
#define Hb ((bf16*)(ws + WS_H))
#define HID ((bf16*)(ws + WS_BIG))
#define QKb ((bf16*)(ws + WS_QK))
#define VTb ((bf16*)(ws + WS_VT))
#define AOb ((bf16*)(ws + WS_AO))
#define GYb ((bf16*)(ws + WS_GY))
#define Ub ((bf16*)(ws + WS_U))
#define UCb ((bf16*)(ws + WS_UC))
#define LAb ((bf16*)(ws + WS_LA))
#define BVb ((bf16*)(ws + WS_BV))
#define LSEb ((float*)(ws + WS_LSE))
#define XBb ((bf16*)(ws + WS_XB))

    {
        PHASE_IDS
        LAS float* scr = (LAS float*)(lds + wave * 8448);
        constexpr int I_W1 = 16 * 128, I_W2 = 64 * 32, I_QK = 16 * 64, I_SQ = 16 * 32, I_G = 4 * 8;
        constexpr int NITEMS = 4 * (I_W1 + I_W2) + 2 * (I_QK + 2 * I_SQ) + (I_QK + 8 * I_G + I_SQ) + (3 * (I_QK + I_SQ) + I_SQ);
#ifndef SK_TR
        for (int it = gw; it < NITEMS; it += ngw) {
            int r = it;
            if (r < 4 * I_W1) { const int l = r / I_W1; transpose_item(args.in[7] + (size_t)l * 1024 * 4096, 4096, 1024, 128, (bf16*)(ws + W_W1) + (size_t)l * 4096 * 1024, 0, 0, scr, r % I_W1, lane); continue; } r -= 4 * I_W1;
            if (r < 4 * I_W2) { const int l = r / I_W2; transpose_item(args.in[8] + (size_t)l * 4096 * 1024, 1024, 4096, 32, (bf16*)(ws + W_W2) + (size_t)l * 1024 * 4096, 0, 0, scr, r % I_W2, lane); continue; } r -= 4 * I_W2;
            if (r < 2 * I_QK) { const int s = r / I_QK; transpose_item(args.in[9] + (size_t)s * 1024 * 3072, 3072, 1024, 64, (bf16*)(ws + W_DAQK) + (size_t)s * 2048 * 1024, 1, 0, scr, r % I_QK, lane); continue; } r -= 2 * I_QK;
            if (r < 2 * I_SQ) { const int s = r / I_SQ; transpose_item(args.in[9] + (size_t)s * 1024 * 3072 + 2048, 3072, 1024, 32, (bf16*)(ws + W_DAV) + (size_t)s * 1024 * 1024, 0, 0, scr, r % I_SQ, lane); continue; } r -= 2 * I_SQ;
            if (r < 2 * I_SQ) { const int s = r / I_SQ; transpose_item(args.in[10] + (size_t)s * 1024 * 1024, 1024, 1024, 32, (bf16*)(ws + W_DAO) + (size_t)s * 1024 * 1024, 0, 0, scr, r % I_SQ, lane); continue; } r -= 2 * I_SQ;
            if (r < I_QK) { transpose_item(args.in[18], 2048, 1024, 64, (bf16*)(ws + W_LIN), 0, 0, scr, r, lane); continue; } r -= I_QK;
            if (r < 8 * I_G) { const int sm = r / I_G, blk = sm >> 1, gate = sm & 1;
                transpose_item(args.in[gate ? 23 : 21] + (size_t)blk * 65536, 256, 256, 8, (bf16*)(ws + W_LG), 2, 512 * blk + 128 * gate, scr, r % I_G, lane); continue; } r -= 8 * I_G;
            if (r < I_SQ) { transpose_item(args.in[26], 1024, 1024, 32, (bf16*)(ws + W_LOUT), 0, 0, scr, r, lane); continue; } r -= I_SQ;
            if (r < 3 * I_QK) { const int g = r / I_QK; transpose_item(args.in[27] + (size_t)g * 3072, 9216, 1024, 64, (bf16*)(ws + W_DLQK) + (size_t)g * 2048 * 1024, 1, 0, scr, r % I_QK, lane); continue; } r -= 3 * I_QK;
            if (r < 3 * I_SQ) { const int g = r / I_SQ; transpose_item(args.in[27] + (size_t)g * 3072 + 2048, 9216, 1024, 32, (bf16*)(ws + W_DLV) + (size_t)g * 1024 * 1024, 0, 0, scr, r % I_SQ, lane); continue; } r -= 3 * I_SQ;
            transpose_item(args.in[28], 1024, 1024, 32, (bf16*)(ws + W_DLO), 0, 0, scr, r, lane);
        }
#endif
        for (int i = gtid; i < 16 * 2048; i += ngt) { const int col = i >> 11, dist = i & 2047; biasT[i] = args.in[2][t5_bucket(dist) * 16 + col] * LOG2E; }
        if (gtid < 1024) ((float*)(ws + WS_SP))[gtid] = -8.0f * log1pf(expf(-args.in[25][gtid]));
        if (bid == 0 && wave == 0) {
            for (int s = 0; s < 2; ++s) {
                const float a = wave_sum(args.in[13][s * 64 + lane] * args.in[14][s * 64 + lane], lane);
                const float b2 = wave_sum(args.in[15][s * 64 + lane] * args.in[16][s * 64 + lane], lane);
                const int layer = 3 * s; const float li = 0.8f - 0.6f * expf(-0.3f * (float)layer);
                if (lane == 0) scal[s] = expf(a) - expf(b2) + li;
            }
        }
        __syncthreads();
#ifndef SK_ADALN
        {
            LAS float* sc = (LAS float*)lds; LAS float* red = (LAS float*)(lds + 131072);
            const float* cin = args.in[1];
            for (int i = tid; i < 32768; i += NT_) { const int b = i & 31, k = i >> 5; const float v = cin[b * 1024 + k]; sc[k * 32 + b] = v / (1.0f + __expf(-v)); }
            __syncthreads();
            for (int item = bid; item < 768; item += G) {
                const int l = item / 192, nb = item - l * 192, col = tid & 31, kg = tid >> 5;
                float a[32];
#pragma unroll
                for (int b = 0; b < 32; ++b) a[b] = 0.f;
                const float* wp = args.in[3] + ((size_t)l * 1024 + kg * 64) * 6144 + nb * 32 + col;
                for (int kk = 0; kk < 64; ++kk) {
                    const float w = wp[(size_t)kk * 6144]; const LAS float* row = sc + (kg * 64 + kk) * 32;
#pragma unroll
                    for (int b4 = 0; b4 < 8; ++b4) { const f32x4 s4 = *(const LAS f32x4*)(row + 4 * b4); a[4 * b4 + 0] += w * s4[0]; a[4 * b4 + 1] += w * s4[1]; a[4 * b4 + 2] += w * s4[2]; a[4 * b4 + 3] += w * s4[3]; }
                }
#pragma unroll
                for (int b = 0; b < 32; ++b) a[b] += shx(a[b], 32, lane);
                for (int w = 0; w < 8; ++w) {
                    if (wave == w && lane < 32) {
#pragma unroll
                        for (int b = 0; b < 32; ++b) { LAS float* p = red + b * 32 + col; *p = (w == 0 ? 0.f : *p) + a[b]; }
                    }
                    __syncthreads();
                }
                for (int i = tid; i < 1024; i += NT_) { const int b = i >> 5, cc = i & 31; mod[((size_t)l * 32 + b) * 6144 + nb * 32 + cc] = red[b * 32 + cc] + args.in[4][l * 6144 + nb * 32 + cc]; }
                __syncthreads();
            }
        }
#endif
    }
    if (args.ws == nullptr) GSYNC_HIP();
    GSYNC();

#pragma nounroll
    for (int layer = 0; layer < 4; ++layer) {
        asm volatile("" : "+s"(ws));
        const int kind = layer % 3, slot = layer / 3;
        const float* modl = mod + (size_t)layer * 32 * 6144;
        if (layer == 0) norm_phase(x_in, args.in[5], modl, modl + 1024, Hb, bid, ngw);
        else norm_phase_b(XBb, args.in[5] + layer * 1024, modl, modl + 1024, Hb, bid, ngw);
        GSYNC();
        const bf16* mixA; const bf16* mixW;
        if (kind == 1) {
#ifndef SK_L_WIN
            {
                pg8::Gemm g{Hb, (const bf16*)(ws + W_LIN), 1024, 1024, 1024, 256, 8, 1, 0}; pg8::StaticOrder S; S.init(256, 8, G, bid);
                pg8::EpiYU E{GYb, Ub}; pg8::gemm_phase<pg8::EpiYU, pg8::StaticOrder>(lds, g, S, E);
            }
#endif
            GSYNC();
#ifndef SK_L_CONV
            {
                PHASE_IDS
                const int ch = (gtid & 127) * 8;
                float cw[4][8], cb[8];
#pragma unroll
                for (int j = 0; j < 8; ++j) { cb[j] = args.in[20][ch + j];
#pragma unroll
                    for (int tap = 0; tap < 4; ++tap) cw[tap][j] = args.in[19][tap * 1024 + ch + j]; }
                for (int it = gtid; it < 131072; it += ngt) {
                    const int bc = it >> 7; const size_t t0 = (size_t)(bc >> 5) * 2048 + (size_t)(bc & 31) * 64; const bool halo = (bc & 31) != 0;
                    const u32x4 z4 = (u32x4){0u, 0u, 0u, 0u};
                    u32x4 p1 = halo ? *(const u32x4*)(Ub + (t0 - 1) * 1024 + ch) : z4, p2 = halo ? *(const u32x4*)(Ub + (t0 - 2) * 1024 + ch) : z4, p3 = halo ? *(const u32x4*)(Ub + (t0 - 3) * 1024 + ch) : z4;
#pragma unroll 4
                    for (int st = 0; st < 64; ++st) {
                        const u32x4 c0 = *(const u32x4*)(Ub + (t0 + st) * 1024 + ch);
                        float a[8];
#pragma unroll
                        for (int j = 0; j < 8; ++j) a[j] = cb[j];
#define CONV_TAP(tap, uw) do { a[0] += cw[tap][0] * bflo(uw.x); a[1] += cw[tap][1] * bfhi(uw.x); a[2] += cw[tap][2] * bflo(uw.y); a[3] += cw[tap][3] * bfhi(uw.y); \
                            a[4] += cw[tap][4] * bflo(uw.z); a[5] += cw[tap][5] * bfhi(uw.z); a[6] += cw[tap][6] * bflo(uw.w); a[7] += cw[tap][7] * bfhi(uw.w); } while (0)
                        CONV_TAP(0, c0); CONV_TAP(1, p1); CONV_TAP(2, p2); CONV_TAP(3, p3);
#undef CONV_TAP
                        u32x4 w; w.x = cvt_pk_bf16(a[0], a[1]); w.y = cvt_pk_bf16(a[2], a[3]); w.z = cvt_pk_bf16(a[4], a[5]); w.w = cvt_pk_bf16(a[6], a[7]);
                        *(u32x4*)(UCb + (t0 + st) * 1024 + ch) = w;
                        p3 = p2; p2 = p1; p1 = c0;
                    }
                }
            }
#endif
            GSYNC();
#ifndef SK_L_GATES
            {
                pg8::Gemm g{UCb, (const bf16*)(ws + W_LG), 1024, 256, 256, 256, 8, 1, 1}; pg8::StaticOrder S; S.init(256, 8, G, bid);
                pg8::EpiGates E{LAb, BVb}; pg8::gemm_phase<pg8::EpiGates, pg8::StaticOrder>(lds, g, S, E);
            }
#endif
            GSYNC();
#ifndef SK_L_SCAN
            { PHASE_IDS
            for (int it = gtid; it < 131072; it += ngt) {
                const int ch = (it & 127) * 8, bc = it >> 7; const size_t t0 = (size_t)(bc >> 5) * 2048 + (size_t)(bc & 31) * 64;
                float h[8], sl[8], sp[8], bxv[8], bav[8];
#pragma unroll
                for (int j = 0; j < 8; ++j) { h[j] = 0.f; sl[j] = 0.f; sp[j] = ((const float*)(ws + WS_SP))[ch + j]; bxv[j] = args.in[22][ch + j]; bav[j] = args.in[24][ch + j]; }
#pragma unroll 2
                for (int st = 0; st < 64; ++st) {
                    const u32x4 lw = *(const u32x4*)(LAb + (t0 + st) * 1024 + ch), bw = *(const u32x4*)(BVb + (t0 + st) * 1024 + ch), uw = *(const u32x4*)(UCb + (t0 + st) * 1024 + ch);
                    float l8[8], b8[8]; lru_coef(lw, bw, uw, sp, bxv, bav, l8, b8);
#pragma unroll
                    for (int j = 0; j < 8; ++j) { sl[j] += l8[j]; h[j] = fast_exp2(l8[j]) * h[j] + b8[j]; }
                }
                float* cs = CS + (size_t)bc * 1024 + ch; float* chp = CH + (size_t)bc * 1024 + ch;
                *(f32x4*)cs = (f32x4){sl[0], sl[1], sl[2], sl[3]}; *(f32x4*)(cs + 4) = (f32x4){sl[4], sl[5], sl[6], sl[7]};
                *(f32x4*)chp = (f32x4){h[0], h[1], h[2], h[3]}; *(f32x4*)(chp + 4) = (f32x4){h[4], h[5], h[6], h[7]};
            } }
            GSYNC();
            { PHASE_IDS
            for (int it = gtid; it < 131072; it += ngt) {
                const int ch = (it & 127) * 8, bc = it >> 7, bb = bc >> 5, chunk = bc & 31; const size_t t0 = (size_t)bb * 2048 + (size_t)chunk * 64;
                float h[8], sp[8], bxv[8], bav[8];
#pragma unroll
                for (int j = 0; j < 8; ++j) { h[j] = 0.f; sp[j] = ((const float*)(ws + WS_SP))[ch + j]; bxv[j] = args.in[22][ch + j]; bav[j] = args.in[24][ch + j]; }
                for (int cc = 0; cc < chunk; ++cc) {
                    const float* cs = CS + (size_t)(bb * 32 + cc) * 1024 + ch; const float* chp = CH + (size_t)(bb * 32 + cc) * 1024 + ch;
                    const f32x4 s0 = *(const f32x4*)cs, s1 = *(const f32x4*)(cs + 4), h0 = *(const f32x4*)chp, h1 = *(const f32x4*)(chp + 4);
#pragma unroll
                    for (int j = 0; j < 4; ++j) { h[j] = fast_exp2(s0[j]) * h[j] + h0[j]; h[4 + j] = fast_exp2(s1[j]) * h[4 + j] + h1[j]; }
                }
#pragma unroll 2
                for (int st = 0; st < 64; ++st) {
                    const u32x4 lw = *(const u32x4*)(LAb + (t0 + st) * 1024 + ch), bw = *(const u32x4*)(BVb + (t0 + st) * 1024 + ch), uw = *(const u32x4*)(UCb + (t0 + st) * 1024 + ch), gw4 = *(const u32x4*)(GYb + (t0 + st) * 1024 + ch);
                    float l8[8], b8[8]; lru_coef(lw, bw, uw, sp, bxv, bav, l8, b8);
                    const float g8[8] = {bflo(gw4.x), bfhi(gw4.x), bflo(gw4.y), bfhi(gw4.y), bflo(gw4.z), bfhi(gw4.z), bflo(gw4.w), bfhi(gw4.w)};
                    float o[8];
#pragma unroll
                    for (int j = 0; j < 8; ++j) { h[j] = fast_exp2(l8[j]) * h[j] + b8[j]; o[j] = h[j] * g8[j]; }
                    u32x4 w; w.x = cvt_pk_bf16(o[0], o[1]); w.y = cvt_pk_bf16(o[2], o[3]); w.z = cvt_pk_bf16(o[4], o[5]); w.w = cvt_pk_bf16(o[6], o[7]);
                    *(u32x4*)(Ub + (t0 + st) * 1024 + ch) = w;
                }
            } }
#endif
            GSYNC();
            mixA = Ub; mixW = (const bf16*)(ws + W_LOUT);
        } else {
            const int ngroups = (kind == 0) ? 1 : 3;
#pragma nounroll
            for (int gi = 0; gi < ngroups; ++gi) {
                const int dil = (kind == 0) ? 1 : (gi == 0 ? 1 : (gi == 1 ? 4 : 16));
                const bf16* wqk = (kind == 0) ? (const bf16*)(ws + W_DAQK) + (size_t)slot * 2048 * 1024 : (const bf16*)(ws + W_DLQK) + (size_t)gi * 2048 * 1024;
                const bf16* wv = (kind == 0) ? (const bf16*)(ws + W_DAV) + (size_t)slot * 1024 * 1024 : (const bf16*)(ws + W_DLV) + (size_t)gi * 1024 * 1024;
                const float* qg = (kind == 0) ? args.in[11] + slot * 64 : args.in[29];
                const float* kg = (kind == 0) ? args.in[12] + slot * 64 : args.in[30];
#ifndef SK_GQK
                {
                    pg8::Gemm g{Hb, wqk, 1024, 1024, 1024, 256, 8, 1, 0}; pg8::StaticOrder S; S.init(256, 8, G, bid);
                    pg8::EpiQK E{QKb, qg, kg}; pg8::gemm_phase<pg8::EpiQK, pg8::StaticOrder>(lds, g, S, E);
                }
#endif
#ifndef SK_GVT
                {
                    pg8::Gemm g{wv, Hb, 1024, dil * 1024, 1024, 4, 256, dil, 0}; pg8::StaticOrder S; S.init(4, 256, G, bid);
                    pg8::EpiBf16<0> E{VTb, (size_t)TOK}; pg8::gemm_phase<pg8::EpiBf16<0>, pg8::StaticOrder>(lds, g, S, E);
                }
#endif
                GSYNC();
                if (kind == 0) {
#ifndef SK_ATT0
                    const float lam = scal[slot]; const float li = 0.8f - 0.6f * expf(-0.3f * (float)layer);
                    int last_hp = -1;
                    if (G == 256) {
                        const int xcd = bid & 7, bslot = bid >> 3, grp = bslot >> 3, pp = bslot & 7;
                        for (int rnd = 0; rnd < 8; ++rnd) {
                            const int bh = 32 * xcd + 4 * rnd + grp;
                            attn_unit<0>(lds, QKb, VTb, biasT, bh >> 3, bh & 7, 0, 1, 15 - pp, AOb, LSEb, 0, lam, args.in[17] + slot * 128, 1.0f - li, (bh & 7) != last_hp); last_hp = bh & 7;
                            attn_unit<0>(lds, QKb, VTb, biasT, bh >> 3, bh & 7, 0, 1, pp, AOb, LSEb, 0, lam, args.in[17] + slot * 128, 1.0f - li, false);
                        }
                    } else
                    for (int u = bid; u < 4096; u += G) { const int bh = u & 255, r = u >> 8;
                        attn_unit<0>(lds, QKb, VTb, biasT, bh >> 3, bh & 7, 0, 1, 15 - r, AOb, LSEb, 0, lam, args.in[17] + slot * 128, 1.0f - li, (bh & 7) != last_hp); last_hp = bh & 7; }
#endif
                } else {
#ifndef SK_ATT1
                    int last_hp = -1;
                    for (int u = bid; u < 4096; u += G) { const int bh = u & 255, r = u >> 8; const int c = r % dil, jb = r / dil;
                        attn_unit<1>(lds, QKb, VTb, biasT, bh >> 3, bh & 7, c, dil, jb, AOb, LSEb, gi, 0.f, nullptr, 0.f, (bh & 7) != last_hp); last_hp = bh & 7; }
#endif
                }
                GSYNC();
            }
            mixA = AOb; mixW = (kind == 0) ? (const bf16*)(ws + W_DAO) + (size_t)slot * 1024 * 1024 : (const bf16*)(ws + W_DLO);
        }
#ifndef SK_GRES
        {
            pg8::Gemm g{mixA, mixW, 1024, 1024, 1024, 256, 4, 1, 0}; pg8::RowOrder S; S.init(256, 4, G, bid);
            pg8::EpiResid E{(layer == 0) ? x_in : (const float*)nullptr, XBb, (float*)nullptr, XBb, modl + 2048}; pg8::gemm_phase<pg8::EpiResid, pg8::RowOrder>(lds, g, S, E);
            norm_panels(XBb, args.in[6] + layer * 1024, modl + 3072, modl + 4096, Hb, bid, G);
        }
#endif
        GSYNC();
#ifndef SK_GUP
        {
            pg8::Gemm g{Hb, (const bf16*)(ws + W_W1) + (size_t)layer * 4096 * 1024, 1024, 1024, 1024, 256, 16, 1, 0}; pg8::StaticOrder S; S.init(256, 16, G, bid);
            pg8::EpiBf16<1> E{HID, (size_t)4096}; pg8::gemm_phase<pg8::EpiBf16<1>, pg8::StaticOrder>(lds, g, S, E);
        }
#endif
        GSYNC();
#ifndef SK_GDOWN
        {
            pg8::Gemm g{HID, (const bf16*)(ws + W_W2) + (size_t)layer * 1024 * 4096, 4096, 4096, 4096, 256, 4, 1, 0}; pg8::StaticOrder S; S.init(256, 4, G, bid);
            pg8::EpiResid E{(const float*)nullptr, XBb, (layer == 3) ? xo : (float*)nullptr, XBb, modl + 5120}; pg8::gemm_phase<pg8::EpiResid, pg8::StaticOrder>(lds, g, S, E);
        }
#endif
        if (layer < 3) GSYNC();
    }
}

extern "C" void kernel_launch(void* const* d_in, const int* in_sizes, int n_in, void* d_out, int out_size, void* d_ws, size_t ws_size, hipStream_t stream) {
    static int grid_blocks = 0;
    if (grid_blocks == 0) {
        if (n_in != 31 || out_size != TOK * DM || ws_size < WS_END) { fprintf(stderr, "kernel_launch: unexpected shapes (n_in %d out %d ws %zu)\n", n_in, out_size, ws_size); grid_blocks = -1; return; }
        int dev = 0, cus = 0, per_cu = 0;
        hipGetDevice(&dev);
        hipDeviceGetAttribute(&cus, hipDeviceAttributeMultiprocessorCount, dev);
        if (hipFuncSetAttribute((const void*)fwd_mega, hipFuncAttributeMaxDynamicSharedMemorySize, LDS_BYTES) != hipSuccess) { fprintf(stderr, "kernel_launch: hipFuncSetAttribute failed\n"); }
        if (hipOccupancyMaxActiveBlocksPerMultiprocessor(&per_cu, (const void*)fwd_mega, NT_, LDS_BYTES) != hipSuccess || per_cu < 1) { fprintf(stderr, "kernel_launch: occupancy query gave %d\n", per_cu); per_cu = 1; }
        (void)hipGetLastError();
        grid_blocks = cus * per_cu;
    }
    if (grid_blocks < 0) return;
    if (hipMemsetAsync((char*)d_ws + WS_BAR, 0, 16384, stream) != hipSuccess) { fprintf(stderr, "kernel_launch: memset of the barrier words failed\n"); return; }
    Args a{};
    for (int i = 0; i < 31; ++i) a.in[i] = (const float*)d_in[i];
    a.out = (float*)d_out; a.ws = (unsigned char*)d_ws;
    void* kargs[] = {&a};
    hipError_t e = hipLaunchCooperativeKernel((const void*)fwd_mega, dim3(grid_blocks), dim3(NT_), kargs, LDS_BYTES, stream);
    if (e != hipSuccess) fprintf(stderr, "cooperative launch failed: %s (grid %d)\n", hipGetErrorString(e), grid_blocks);
}
```

```cpp
#include <hip/hip_runtime.h>
#include <hip/hip_cooperative_groups.h>
#include <cstdio>
#include <cstdint>
namespace cg = cooperative_groups;

#define LAS __attribute__((address_space(3)))
#define GAS __attribute__((address_space(1)))
typedef unsigned short bf16;
typedef short bf16x8 __attribute__((ext_vector_type(8)));
typedef short s16x4 __attribute__((ext_vector_type(4)));
typedef float f32x4 __attribute__((ext_vector_type(4)));
typedef float f32x16 __attribute__((ext_vector_type(16)));
typedef unsigned u32x4 __attribute__((ext_vector_type(4)));
typedef unsigned u32x2 __attribute__((ext_vector_type(2)));

constexpr int NT_ = 512;
constexpr int TOK = 65536, DM = 1024, SEQ = 2048, NB = 32, DFF = 4096;
constexpr float LOG2E = 1.4426950408889634f;
constexpr float RMS_EPS = 1e-6f;
constexpr int LDS_XB_OFF = 139264 - 16;
constexpr int LDS_BYTES = 139264;

constexpr size_t MiB = 1u << 20;
constexpr size_t WS_SCAL = 0;
constexpr size_t WS_BAR = 128 * 1024;
constexpr size_t WS_SP = 64 * 1024;
constexpr size_t WS_MOD = 1 * MiB;
constexpr size_t WS_BIAS = 4 * MiB;
constexpr size_t WS_CS = 5 * MiB;
constexpr size_t WS_CH = 9 * MiB;
constexpr size_t WS_W = 16 * MiB;
constexpr size_t W_W1 = WS_W;
constexpr size_t W_W2 = W_W1 + 32 * MiB;
constexpr size_t W_DAQK = W_W2 + 32 * MiB;
constexpr size_t W_DAV = W_DAQK + 8 * MiB;
constexpr size_t W_DAO = W_DAV + 4 * MiB;
constexpr size_t W_LIN = W_DAO + 4 * MiB;
constexpr size_t W_LG = W_LIN + 4 * MiB;
constexpr size_t W_LOUT = W_LG + 1 * MiB;
constexpr size_t W_DLQK = W_LOUT + 2 * MiB;
constexpr size_t W_DLV = W_DLQK + 12 * MiB;
constexpr size_t W_DLO = W_DLV + 6 * MiB;
constexpr size_t W_END = W_DLO + 2 * MiB;
static_assert(W_END <= 128 * MiB, "weights fit");
constexpr size_t WS_H = 128 * MiB;
constexpr size_t WS_BIG = 256 * MiB;
constexpr size_t WS_QK = WS_BIG;
constexpr size_t WS_VT = WS_BIG + 256 * MiB;
constexpr size_t WS_AO = WS_BIG + 384 * MiB;
constexpr size_t WS_GY = WS_BIG;
constexpr size_t WS_U = WS_BIG + 128 * MiB;
constexpr size_t WS_UC = WS_BIG + 256 * MiB;
constexpr size_t WS_LA = WS_BIG + 384 * MiB;
constexpr size_t WS_BV = WS_H;
constexpr size_t WS_LSE = 768 * MiB;
constexpr size_t WS_XB = 776 * MiB;
constexpr size_t WS_END = 904 * MiB;

__device__ __forceinline__ int opaque_tid() { int t = threadIdx.x; asm volatile("" : "+v"(t)); return t; }
typedef float f32x2_t __attribute__((ext_vector_type(2))); typedef __bf16 bf16x2_t __attribute__((ext_vector_type(2)));
__device__ __forceinline__ unsigned cvt_pk_bf16(float lo, float hi) { f32x2_t v = {lo, hi}; bf16x2_t b = __builtin_convertvector(v, bf16x2_t); return __builtin_bit_cast(unsigned, b); }
__device__ __forceinline__ float shx(float v, int m, int lane) { return __int_as_float(__builtin_amdgcn_ds_bpermute((lane ^ m) << 2, __float_as_int(v))); }
__device__ __forceinline__ float wave_sum(float v, int lane) {
#pragma unroll
    for (int o = 1; o < 64; o <<= 1) v += shx(v, o, lane);
    return v;
}
__device__ __forceinline__ float max_x32(float v) { auto rr = __builtin_amdgcn_permlane32_swap(__float_as_uint(v), __float_as_uint(v), false, false); return fmaxf(__uint_as_float(rr[0]), __uint_as_float(rr[1])); }
__device__ __forceinline__ float sum_x32(float v) { auto rr = __builtin_amdgcn_permlane32_swap(__float_as_uint(v), __float_as_uint(v), false, false); return __uint_as_float(rr[0]) + __uint_as_float(rr[1]); }
__device__ __forceinline__ float bf2f(unsigned short h) { return __uint_as_float(((unsigned)h) << 16); }
__device__ __forceinline__ float bflo(unsigned w) { return __uint_as_float(w << 16); }
__device__ __forceinline__ float bfhi(unsigned w) { return __uint_as_float(w & 0xffff0000u); }
__device__ __forceinline__ float fast_exp2(float x) { return __builtin_amdgcn_exp2f(x); }
__device__ __forceinline__ float sigmoidf_(float x) { return 1.0f / (1.0f + __expf(-x)); }

namespace pg8 {
constexpr int BM = 256, BK = 64, HALF = 128, HTB = HALF * BK * 2, STAGE_BYTES = 8 * HTB, NXCD = 8, WGM = 8;
__host__ __device__ __forceinline__ int lds_byte(int r, int c) { const int st = (r >> 4) * 2 + (c >> 5), rr = r & 15, cc = c & 31, ob = rr * 64 + cc * 2; return st * 1024 + (ob ^ (((ob >> 9) & 1) << 5)); }
__host__ __device__ __forceinline__ void stage_rc(int b, int& R, int& C) { const int st = b / 1024, sb = b % 1024, swz = sb ^ (((sb >> 9) & 1) << 5); R = (st >> 1) * 16 + swz / 64; C = (st & 1) * 32 + (swz % 64) / 2; }
__host__ __device__ __forceinline__ int perm32(int rho) { const int n = rho >> 4, i = rho & 15; return 8 * (i >> 2) + 4 * n + (i & 3); }

struct Unit { int pm, pn; };
struct Gemm { const bf16* A; const bf16* Bt; int lda, ldb, K, nM, nN, dil, agrp; };

__device__ __forceinline__ const char* baseA(const Gemm& g, const Unit& u) {
    return (const char*)(g.A + (size_t)u.pm * 256 * g.lda + (g.agrp ? (u.pn >> 1) * 256 : 0));
}
__device__ __forceinline__ const char* baseB(const Gemm& g, const Unit& u) {
    if (g.dil == 1) return (const char*)(g.Bt + (size_t)u.pn * 256 * g.ldb);
    const int b = u.pn >> 3, q = u.pn & 7;
    int tok;
    if (g.dil == 4) tok = b * 2048 + (q & 1) * 256 * 4 + (q >> 1);
    else tok = b * 2048 + 2 * q;
    return (const char*)(g.Bt + (size_t)tok * 1024);
}

struct StaticOrder {
    int nM, nN, nwg, G, c;
    __device__ void init(int nM_, int nN_, int G_, int c_) { nM = nM_; nN = nN_; nwg = nM * nN; G = G_; c = c_; }
    __device__ bool next(int i, Unit& u) const {
        const long L = (long)i * G + c; if (L >= nwg) return false;
        int wgid = (int)L; { const int q = nwg / NXCD, r = nwg % NXCD, xcd = wgid % NXCD, off = wgid / NXCD; wgid = (xcd < r ? xcd * (q + 1) : r * (q + 1) + (xcd - r) * q) + off; }
        const int nig = WGM * nN, gid = wgid / nig, fm = gid * WGM, gsz = (nM - fm) < WGM ? (nM - fm) : WGM;
        u.pm = fm + ((wgid % nig) % gsz); u.pn = (wgid % nig) / gsz; return true;
    }
};

struct RowOrder {
    int nM, nN, nwg, G, c;
    __device__ void init(int nM_, int nN_, int G_, int c_) { nM = nM_; nN = nN_; nwg = nM * nN; G = G_; c = c_; }
    __device__ bool next(int i, Unit& u) const { const int r = i / nN, pn = i - r * nN, pm = c + r * G; if (pm >= nM) return false; u.pm = pm; u.pn = pn; return true; }
};


template <int ACT> struct EpiBf16 {
    static constexpr bool PERM = true;
    bf16* O; size_t ldc;
    __device__ __forceinline__ void operator()(const f32x4 (&acc)[2][2][4][2], const Unit& u, int wr, int wc, int fr, int fq) const {
        const int row0 = u.pm * BM + wr * 64 + fr; const int col0 = u.pn * BM + wc * 32 + 8 * fq;
#pragma unroll
        for (int ai = 0; ai < 2; ++ai)
#pragma unroll
            for (int m = 0; m < 4; ++m) { bf16* rowp = O + (size_t)(row0 + ai * HALF + m * 16) * ldc + col0;
#pragma unroll
                for (int bj = 0; bj < 2; ++bj) { f32x4 v0 = acc[ai][bj][m][0], v1 = acc[ai][bj][m][1];
                    if (ACT == 1) {
#pragma unroll
                        for (int e = 0; e < 4; ++e) { float a = fmaxf(v0[e], 0.f), b = fmaxf(v1[e], 0.f); v0[e] = a * a; v1[e] = b * b; } }
                    u32x4 w; w.x = cvt_pk_bf16(v0[0], v0[1]); w.y = cvt_pk_bf16(v0[2], v0[3]); w.z = cvt_pk_bf16(v1[0], v1[1]); w.w = cvt_pk_bf16(v1[2], v1[3]);
                    *(u32x4*)(rowp + bj * HALF) = w; } }
    }
};

struct EpiYU {
    static constexpr bool PERM = true;
    bf16* GY; bf16* U;
    static __device__ __forceinline__ float gelu_t(float y) {
        const float z2 = 1.5957691216057308f * (y + 0.044715f * y * y * y);
        return y * __builtin_amdgcn_rcpf(1.0f + __builtin_amdgcn_exp2f(-z2 * LOG2E));
    }
    __device__ __forceinline__ void operator()(const f32x4 (&acc)[2][2][4][2], const Unit& u, int wr, int wc, int fr, int fq) const {
        const bool isy = u.pn < 4; bf16* base = isy ? GY : U;
        const int row0 = u.pm * BM + wr * 64 + fr; const int col0 = (u.pn & 3) * BM + wc * 32 + 8 * fq;
#pragma unroll
        for (int ai = 0; ai < 2; ++ai)
#pragma unroll
            for (int m = 0; m < 4; ++m) { bf16* rowp = base + (size_t)(row0 + ai * HALF + m * 16) * 1024 + col0;
#pragma unroll
                for (int bj = 0; bj < 2; ++bj) { f32x4 v0 = acc[ai][bj][m][0], v1 = acc[ai][bj][m][1];
                    asm volatile("" : "+v"(v0), "+v"(v1));
                    if (isy) {
#pragma unroll
                        for (int e = 0; e < 4; ++e) { v0[e] = gelu_t(v0[e]); v1[e] = gelu_t(v1[e]); } }
                    u32x4 w; w.x = cvt_pk_bf16(v0[0], v0[1]); w.y = cvt_pk_bf16(v0[2], v0[3]); w.z = cvt_pk_bf16(v1[0], v1[1]); w.w = cvt_pk_bf16(v1[2], v1[3]);
                    *(u32x4*)(rowp + bj * HALF) = w; }
                asm volatile("" ::: "memory"); }
    }
};

struct EpiQK {
    static constexpr bool PERM = true;
    bf16* O; const float* qg; const float* kg;
    __device__ __forceinline__ void operator()(const f32x4 (&acc)[2][2][4][2], const Unit& u, int wr, int wc, int fr, int fq) const {
        const bool isq = u.pn < 4; const float* gp = isq ? qg : kg; const float mult = isq ? 0.125f * LOG2E : 1.0f;
        const int row0 = u.pm * BM + wr * 64 + fr; const int col0 = u.pn * BM + wc * 64 + 8 * fq;
        f32x4 gv[2][2];
#pragma unroll
        for (int bj = 0; bj < 2; ++bj)
#pragma unroll
            for (int n = 0; n < 2; ++n) gv[bj][n] = *(const f32x4*)(gp + 32 * bj + 8 * fq + 4 * n);
#pragma unroll
        for (int ai = 0; ai < 2; ++ai)
#pragma unroll
            for (int m = 0; m < 4; ++m) {
                float ss = 0.f;
                f32x4 xv[2][2];
#pragma unroll
                for (int bj = 0; bj < 2; ++bj)
#pragma unroll
                    for (int n = 0; n < 2; ++n) xv[bj][n] = acc[ai][bj][m][n];
                asm volatile("" : "+v"(xv[0][0]), "+v"(xv[0][1]), "+v"(xv[1][0]), "+v"(xv[1][1]));
#pragma unroll
                for (int bj = 0; bj < 2; ++bj)
#pragma unroll
                    for (int n = 0; n < 2; ++n) { const f32x4 x = xv[bj][n]; ss += (x[0] * x[0] + x[1] * x[1]) + (x[2] * x[2] + x[3] * x[3]); }
                { const int ln = fq * 16 + fr; ss += shx(ss, 16, ln); ss += shx(ss, 32, ln); }
                const float rs = rsqrtf(ss * (1.0f / 64.0f) + RMS_EPS) * mult;
                bf16* rowp = O + (size_t)(row0 + ai * HALF + m * 16) * 2048 + col0;
#pragma unroll
                for (int bj = 0; bj < 2; ++bj) { const f32x4 v0 = xv[bj][0] * gv[bj][0] * rs, v1 = xv[bj][1] * gv[bj][1] * rs;
                    u32x4 w; w.x = cvt_pk_bf16(v0[0], v0[1]); w.y = cvt_pk_bf16(v0[2], v0[3]); w.z = cvt_pk_bf16(v1[0], v1[1]); w.w = cvt_pk_bf16(v1[2], v1[3]);
                    *(u32x4*)(rowp + bj * 32) = w; }
                asm volatile("" ::: "memory"); }
    }
};

struct EpiGates {
    static constexpr bool PERM = true;
    bf16* GX; bf16* GA;
    __device__ __forceinline__ void operator()(const f32x4 (&acc)[2][2][4][2], const Unit& u, int wr, int wc, int fr, int fq) const {
        const int ch0 = (u.pn >> 1) * 256 + (u.pn & 1) * 128 + wc * 32 + 8 * fq;
        const int row0 = u.pm * BM + wr * 64 + fr;
#pragma unroll
        for (int ai = 0; ai < 2; ++ai)
#pragma unroll
            for (int m = 0; m < 4; ++m) {
                const size_t off = (size_t)(row0 + ai * HALF + m * 16) * 1024 + ch0;
                const f32x4 x0 = acc[ai][0][m][0], x1 = acc[ai][0][m][1], a0 = acc[ai][1][m][0], a1 = acc[ai][1][m][1];
                u32x4 w1, w2;
                w1.x = cvt_pk_bf16(x0[0], x0[1]); w1.y = cvt_pk_bf16(x0[2], x0[3]); w1.z = cvt_pk_bf16(x1[0], x1[1]); w1.w = cvt_pk_bf16(x1[2], x1[3]);
                w2.x = cvt_pk_bf16(a0[0], a0[1]); w2.y = cvt_pk_bf16(a0[2], a0[3]); w2.z = cvt_pk_bf16(a1[0], a1[1]); w2.w = cvt_pk_bf16(a1[2], a1[3]);
                *(u32x4*)(GX + off) = w1; *(u32x4*)(GA + off) = w2;
            }
    }
};

struct EpiResid {
    static constexpr bool PERM = true;
    const float* xin_f32; const bf16* xin_b; float* xout_f32; bf16* xout_b; const float* gate;
    __device__ __forceinline__ void operator()(const f32x4 (&acc)[2][2][4][2], const Unit& u, int wr, int wc, int fr, int fq) const {
        const int col0 = u.pn * BM + wc * 32 + 8 * fq; const int row0 = u.pm * BM + wr * 64 + fr;
        const float* gp = gate + (size_t)(u.pm >> 3) * 6144 + col0;
        f32x4 gv[2][2];
#pragma unroll
        for (int bj = 0; bj < 2; ++bj)
#pragma unroll
            for (int n = 0; n < 2; ++n) gv[bj][n] = *(const f32x4*)(gp + bj * HALF + n * 4);
#pragma unroll
        for (int ai = 0; ai < 2; ++ai)
#pragma unroll
            for (int m = 0; m < 4; ++m) { const size_t off = (size_t)(row0 + ai * HALF + m * 16) * 1024 + col0;
#pragma unroll
                for (int bj = 0; bj < 2; ++bj) {
                    f32x4 x0, x1;
                    if (xin_f32) { x0 = *(const f32x4*)(xin_f32 + off + bj * HALF); x1 = *(const f32x4*)(xin_f32 + off + bj * HALF + 4); }
                    else { const u32x4 w = *(const u32x4*)(xin_b + off + bj * HALF); x0 = (f32x4){bflo(w.x), bfhi(w.x), bflo(w.y), bfhi(w.y)}; x1 = (f32x4){bflo(w.z), bfhi(w.z), bflo(w.w), bfhi(w.w)}; }
                    x0 = x0 + gv[bj][0] * acc[ai][bj][m][0]; x1 = x1 + gv[bj][1] * acc[ai][bj][m][1];
                    if (xout_f32) { *(f32x4*)(xout_f32 + off + bj * HALF) = x0; *(f32x4*)(xout_f32 + off + bj * HALF + 4) = x1; }
                    else { u32x4 w; w.x = cvt_pk_bf16(x0[0], x0[1]); w.y = cvt_pk_bf16(x0[2], x0[3]); w.z = cvt_pk_bf16(x1[0], x1[1]); w.w = cvt_pk_bf16(x1[2], x1[3]); *(u32x4*)(xout_b + off + bj * HALF) = w; }
                } }
    }
};

template <class Epi, class Sched>
__device__ __forceinline__ void gemm_phase(LAS unsigned char* lds, Gemm g, Sched S, const Epi& E) {
    asm volatile("" : "+s"(g.A), "+s"(g.Bt), "+s"(S.c), "+s"(S.G));
    const int tid = opaque_tid(), wid = __builtin_amdgcn_readfirstlane(tid >> 6), lane = tid & 63, wr = wid >> 2, wc = wid & 3, fr = lane & 15, fq = lane >> 4;
    const int K = g.K, nt = K / BK;
    unsigned voffA[2], voffB[2];
#pragma unroll
    for (int i = 0; i < 2; ++i) { int R, C; stage_rc(tid * 16 + i * 8192, R, C); const int Rb = Epi::PERM ? ((R & ~31) + perm32(R & 31)) : R;
        voffA[i] = (unsigned)(R * g.lda + C) * 2u; voffB[i] = (unsigned)(Rb * g.ldb + C) * 2u; }
    const size_t kstep = (size_t)(BK * 2);
    const size_t hstepA = (size_t)HALF * g.lda * 2;
    const size_t hstepB = (g.dil == 16) ? (size_t)2048 : (size_t)HALF * g.ldb * 2;
    const unsigned ldsw = (unsigned)wid * 1024u;
    const int aoff = lds_byte(wr * 64 + fr, fq * 8), boff = lds_byte(wc * 32 + fr, fq * 8);
#define PG8_SA(b, h) (((b) * 2 + (h)) * HTB)
#define PG8_SB(b, h) ((4 + (b) * 2 + (h)) * HTB)
#define PG8_STAGE(bufoff, gbase, voff) do { const char* _gb = (const char*)(gbase); asm("" : "+s"(_gb)); _Pragma("unroll") for (int _i = 0; _i < 2; ++_i) \
        __builtin_amdgcn_global_load_lds((const unsigned*)(_gb + (voff)[_i]), (LAS unsigned*)(lds + (bufoff) + ldsw + _i * 8192), 16, 0, 0); } while (0)
#define PG8_LDA(dst, b, h) do { _Pragma("unroll") for (int m = 0; m < 4; ++m) _Pragma("unroll") for (int k = 0; k < 2; ++k) dst[m][k] = *(const LAS bf16x8*)(lds + PG8_SA(b, h) + aoff + m * 2048 + k * 1024); } while (0)
#define PG8_LDB(dst, b, h) do { _Pragma("unroll") for (int n = 0; n < 2; ++n) _Pragma("unroll") for (int k = 0; k < 2; ++k) dst[n][k] = *(const LAS bf16x8*)(lds + PG8_SB(b, h) + boff + n * 2048 + k * 1024); } while (0)
#define PG8_MMA(ai, bj, At, Bt) do { __builtin_amdgcn_s_setprio(1); _Pragma("unroll") for (int m = 0; m < 4; ++m) _Pragma("unroll") for (int n = 0; n < 2; ++n) _Pragma("unroll") for (int k = 0; k < 2; ++k) \
        acc[ai][bj][m][n] = __builtin_amdgcn_mfma_f32_16x16x32_bf16(Bt[n][k], At[m][k], acc[ai][bj][m][n], 0, 0, 0); __builtin_amdgcn_s_setprio(0); } while (0)
#define PG8_WAIT_V(n) asm volatile("s_waitcnt vmcnt(" #n ")" ::: "memory")
#define PG8_WAIT_L(n) asm volatile("s_waitcnt lgkmcnt(" #n ")" ::: "memory")
#define PG8_BAR __builtin_amdgcn_s_barrier()
#define PG8_SCHED __builtin_amdgcn_sched_barrier(0)
    Unit cur, nxt; int ui = 0;
    if (!S.next(0, cur)) return;
    f32x4 acc[2][2][4][2];
#pragma unroll
    for (int a = 0; a < 2; ++a)
#pragma unroll
        for (int b = 0; b < 2; ++b)
#pragma unroll
            for (int m = 0; m < 4; ++m)
#pragma unroll
                for (int n = 0; n < 2; ++n) acc[a][b][m][n] = (f32x4){0.f, 0.f, 0.f, 0.f};
    bf16x8 At[4][2], B0[2][2], B1[2][2];
    const char* cA = baseA(g, cur); const char* cB = baseB(g, cur);
    PG8_STAGE(PG8_SB(0, 0), cB, voffB); PG8_STAGE(PG8_SB(0, 1), cB + hstepB, voffB); PG8_STAGE(PG8_SA(0, 0), cA, voffA); PG8_STAGE(PG8_SA(0, 1), cA + hstepA, voffA);
    if (wr == 1) PG8_BAR;
    PG8_WAIT_V(2); PG8_BAR;
    PG8_STAGE(PG8_SB(1, 0), cB + kstep, voffB); PG8_STAGE(PG8_SA(1, 0), cA + kstep, voffA); PG8_STAGE(PG8_SB(1, 1), cB + hstepB + kstep, voffB);
    PG8_WAIT_V(6); PG8_BAR;
    for (;;) {
        const bool has_next = S.next(ui + 1, nxt);
        const char* nA = has_next ? baseA(g, nxt) : cA; const char* nB = has_next ? baseB(g, nxt) : cB;
        for (int t = 0; t < nt; t += 2) {
            const bool last = (t == nt - 2);
            const char* a1 = cA + (size_t)(t + 1) * kstep;
            const char* a2 = last ? nA : cA + (size_t)(t + 2) * kstep; const char* b2 = last ? nB : cB + (size_t)(t + 2) * kstep;
            const char* a3 = a2 + kstep; const char* b3 = b2 + kstep;
            PG8_LDB(B0, 0, 0); PG8_LDB(B1, 0, 1); PG8_SCHED; PG8_LDA(At, 0, 0); PG8_STAGE(PG8_SA(1, 1), a1 + hstepA, voffA);
            PG8_WAIT_V(8); PG8_WAIT_L(0); PG8_BAR; PG8_MMA(0, 0, At, B0); PG8_MMA(0, 1, At, B1); PG8_BAR; PG8_SCHED;
            PG8_LDA(At, 0, 1); PG8_STAGE(PG8_SB(0, 0), b2, voffB); PG8_STAGE(PG8_SB(0, 1), b2 + hstepB, voffB); PG8_STAGE(PG8_SA(0, 0), a2, voffA);
            PG8_WAIT_V(8); PG8_WAIT_L(0); PG8_BAR; PG8_MMA(1, 0, At, B0); PG8_MMA(1, 1, At, B1); PG8_BAR; PG8_SCHED;
            PG8_LDB(B0, 1, 0); PG8_LDB(B1, 1, 1); PG8_SCHED; PG8_LDA(At, 1, 0); PG8_STAGE(PG8_SA(0, 1), a2 + hstepA, voffA);
            PG8_WAIT_V(8); PG8_WAIT_L(0); PG8_BAR; PG8_MMA(0, 0, At, B0); PG8_MMA(0, 1, At, B1); PG8_BAR; PG8_SCHED;
            PG8_LDA(At, 1, 1); PG8_STAGE(PG8_SB(1, 0), b3, voffB); PG8_STAGE(PG8_SB(1, 1), b3 + hstepB, voffB); PG8_STAGE(PG8_SA(1, 0), a3, voffA);
            PG8_WAIT_V(8); PG8_WAIT_L(0); PG8_BAR; PG8_MMA(1, 0, At, B0); PG8_MMA(1, 1, At, B1); PG8_BAR; PG8_SCHED;
        }
        if (wr == 0) PG8_BAR;
        { const int te = opaque_tid(), we = __builtin_amdgcn_readfirstlane(te >> 6), le = te & 63;
          E(acc, cur, we >> 2, we & 3, le & 15, le >> 4); }
        if (!has_next) break;
#pragma unroll
        for (int a = 0; a < 2; ++a)
#pragma unroll
            for (int b = 0; b < 2; ++b)
#pragma unroll
                for (int m = 0; m < 4; ++m)
#pragma unroll
                    for (int n = 0; n < 2; ++n) acc[a][b][m][n] = (f32x4){0.f, 0.f, 0.f, 0.f};
        cur = nxt; cA = nA; cB = nB; ++ui;
        if (wr == 1) PG8_BAR;
    }
    PG8_WAIT_V(0);
    PG8_BAR;
#undef PG8_SA
#undef PG8_SB
#undef PG8_STAGE
#undef PG8_LDA
#undef PG8_LDB
#undef PG8_MMA
#undef PG8_WAIT_V
#undef PG8_WAIT_L
#undef PG8_BAR
#undef PG8_SCHED
}
}

constexpr int AT_KROW = 272, AT_VROW = 136, AT_KBYTES = 64 * AT_KROW, AT_VBYTES = 128 * AT_VROW, AT_BUF = AT_KBYTES + AT_VBYTES;
constexpr int AT_BIAS_OFF = 2 * AT_BUF;
template <int MODE>
__device__ __forceinline__ void attn_unit(LAS unsigned char* lds, const bf16* QK, const bf16* Vt, const float* biasT,
                                          int b, int hp, int c, int dil, int jblk, bf16* AO, float* LSE, int gidx,
                                          float lam, const float* subgain, float one_m_li, bool load_bias) {
    constexpr int NDV = (MODE == 0) ? 4 : 2;
    const int tid = opaque_tid(), lane = tid & 63, wid = __builtin_amdgcn_readfirstlane(tid >> 6);
    const int mp = wid >> 2, wq = wid & 3, r32 = lane & 31, hi = lane >> 5;
    const int L = SEQ / dil;
    const size_t tok0 = (size_t)b * SEQ + c;
    const size_t vcol0 = (size_t)b * SEQ + (size_t)c * L;
    LAS float* biasL = (LAS float*)(lds + AT_BIAS_OFF);
    if (load_bias) {
        if (MODE == 0) {
            float tb[8];
#pragma unroll
            for (int k = 0; k < 8; ++k) { const int i = tid + NT_ * k; tb[k] = biasT[(size_t)(2 * hp + (i >> 11)) * 2048 + (i & 2047)]; }
#pragma unroll
            for (int k = 0; k < 8; ++k) { const int i = tid + NT_ * k; biasL[i] = tb[k]; }
        } else {
            for (int i = tid; i < 2 * 129; i += NT_) { const int mm = i / 129, ii = i - mm * 129; biasL[mm * 2048 + ii] = biasT[(size_t)(2 * hp + mm) * 2048 + min(ii * dil, 2047)]; }
        }
    }
    const int q_lo = 128 * jblk + 32 * wq;
    const int qi = q_lo + r32;
    const size_t qtok = tok0 + (size_t)qi * dil;
    bf16x8 qf[4];
#pragma unroll
    for (int ds = 0; ds < 4; ++ds) qf[ds] = *(const bf16x8*)(QK + qtok * 2048 + (2 * hp + mp) * 64 + 16 * ds + 8 * hi);
    const int kt_hi = 2 * jblk + 1;
    const int kt_lo = (MODE == 0) ? 0 : ((jblk > 0) ? 2 * jblk - 2 : 0);
    const int kp_row0 = tid >> 4, kp_c = tid & 15;
    const int vp_row0 = tid >> 3, vp_c = tid & 7;
    const bf16* ksrc = QK + 1024 + 2 * hp * 64 + kp_c * 8;
    const bf16* vsrc = Vt + (size_t)(2 * hp * 64 + vp_row0) * TOK + vcol0 + vp_c * 8;
    u32x4 kr0, kr1, vr0, vr1;
    {
        const int kv0 = 64 * kt_lo;
        kr0 = *(const u32x4*)(ksrc + (tok0 + (size_t)(kv0 + kp_row0) * dil) * 2048);
        kr1 = *(const u32x4*)(ksrc + (tok0 + (size_t)(kv0 + kp_row0 + 32) * dil) * 2048);
        vr0 = *(const u32x4*)(vsrc + kv0);
        vr1 = *(const u32x4*)(vsrc + (size_t)64 * TOK + kv0);
        LAS unsigned char* kb = lds; LAS unsigned char* vb = lds + AT_KBYTES;
        *(LAS u32x4*)(kb + kp_row0 * AT_KROW + kp_c * 16) = kr0; *(LAS u32x4*)(kb + (kp_row0 + 32) * AT_KROW + kp_c * 16) = kr1;
        { LAS unsigned char* p0 = vb + vp_row0 * AT_VROW + vp_c * 16; LAS unsigned char* p1 = vb + (vp_row0 + 64) * AT_VROW + vp_c * 16;
          *(LAS u32x2*)p0 = (u32x2){vr0.x, vr0.y}; *(LAS u32x2*)(p0 + 8) = (u32x2){vr0.z, vr0.w}; *(LAS u32x2*)p1 = (u32x2){vr1.x, vr1.y}; *(LAS u32x2*)(p1 + 8) = (u32x2){vr1.z, vr1.w}; }
    }
    f32x16 acc[NDV];
#pragma unroll
    for (int i = 0; i < NDV; ++i)
#pragma unroll
        for (int r = 0; r < 16; ++r) acc[i][r] = 0.f;
    float mrun = -1e30f, lsum = 0.f;
    float la_pre = 0.f; u32x2 pw_pre[NDV][4];
    if (MODE == 1 && gidx > 0) {
        la_pre = LSE[qtok * 16 + 2 * hp + mp];
#pragma unroll
        for (int dvb = 0; dvb < NDV; ++dvb)
#pragma unroll
            for (int g4 = 0; g4 < 4; ++g4) pw_pre[dvb][g4] = *(const u32x2*)(AO + qtok * 1024 + (2 * hp + mp) * 64 + 32 * dvb + 8 * g4 + 4 * hi);
    }
    const int dvoff = (MODE == 0) ? 0 : 64 * mp;
    for (int kt = kt_lo; kt <= kt_hi; ++kt) {
        const int bufsel = (kt - kt_lo) & 1;
        __syncthreads();
        const bool more = kt < kt_hi;
        if (more) {
            const int kv1 = 64 * (kt + 1);
            kr0 = *(const GAS u32x4*)(ksrc + (tok0 + (size_t)(kv1 + kp_row0) * dil) * 2048);
            kr1 = *(const GAS u32x4*)(ksrc + (tok0 + (size_t)(kv1 + kp_row0 + 32) * dil) * 2048);
            vr0 = *(const GAS u32x4*)(vsrc + kv1);
            vr1 = *(const GAS u32x4*)(vsrc + (size_t)64 * TOK + kv1);
            asm volatile("" ::: "memory");
        }
        const int kv0 = 64 * kt;
        bool skip = kv0 > q_lo + 31;
        if (MODE == 1) skip = skip || (kv0 + 63 < q_lo - 128);
        if (!skip) {
            const LAS unsigned char* kb = lds + bufsel * AT_BUF; const LAS unsigned char* vb = kb + AT_KBYTES;
            f32x16 s0, s1;
#pragma unroll
            for (int r = 0; r < 16; ++r) { s0[r] = 0.f; s1[r] = 0.f; }
            {
                bf16x8 ka[4], kc[4];
#pragma unroll
                for (int ds = 0; ds < 4; ++ds) {
                    ka[ds] = *(const LAS bf16x8*)(kb + r32 * AT_KROW + mp * 128 + (16 * ds + 8 * hi) * 2);
                    kc[ds] = *(const LAS bf16x8*)(kb + (32 + r32) * AT_KROW + mp * 128 + (16 * ds + 8 * hi) * 2);
                }
                __builtin_amdgcn_sched_barrier(0);
#pragma unroll
                for (int ds = 0; ds < 4; ++ds) {
                    s0 = __builtin_amdgcn_mfma_f32_32x32x16_bf16(ka[ds], qf[ds], s0, 0, 0, 0);
                    s1 = __builtin_amdgcn_mfma_f32_32x32x16_bf16(kc[ds], qf[ds], s1, 0, 0, 0);
                }
            }
            const int relbase = qi - kv0 - 4 * hi;
            constexpr int cmax = (MODE == 0) ? 2047 : 128;
            float mx = -1e30f;
            bool interior = (kv0 + 63 <= q_lo);
            if (MODE == 1) interior = interior && (q_lo + 31 - kv0 <= 128);
            if (interior) {
                const LAS float* p = biasL + mp * 2048 + (relbase - 59);
#pragma unroll
                for (int r = 0; r < 16; ++r) {
                    const int o = 59 - ((r & 3) + 8 * (r >> 2));
                    s0[r] += p[o]; s1[r] += p[o - 32];
                    mx = fmaxf(mx, fmaxf(s0[r], s1[r]));
                }
            } else {
                const volatile LAS float* bl = (const volatile LAS float*)(biasL + mp * 2048);
                float bb0[16], bb1[16];
#pragma unroll
                for (int r = 0; r < 16; ++r) {
                    const int rel0 = relbase - ((r & 3) + 8 * (r >> 2));
                    bb0[r] = bl[min(max(rel0, 0), cmax)]; bb1[r] = bl[min(max(rel0 - 32, 0), cmax)];
                }
#pragma unroll
                for (int r = 0; r < 16; ++r) {
                    const int rel0 = relbase - ((r & 3) + 8 * (r >> 2)), rel1 = rel0 - 32;
                    bool ok0 = rel0 >= 0, ok1 = rel1 >= 0;
                    if (MODE == 1) { ok0 = ok0 && (rel0 <= 128); ok1 = ok1 && (rel1 <= 128); }
                    const float t0 = s0[r] + bb0[r], t1 = s1[r] + bb1[r];
                    s0[r] = ok0 ? t0 : -1e30f; s1[r] = ok1 ? t1 : -1e30f;
                    mx = fmaxf(mx, fmaxf(s0[r], s1[r]));
                }
            }
            mx = max_x32(mx);
            const float mnew = fmaxf(mrun, mx);
            const float alpha = fast_exp2(mrun - mnew);
            mrun = mnew;
            float ps = 0.f;
#pragma unroll
            for (int r = 0; r < 16; ++r) { s0[r] = fast_exp2(s0[r] - mnew); s1[r] = fast_exp2(s1[r] - mnew); ps += s0[r] + s1[r]; }
            lsum = lsum * alpha + ps;
#pragma unroll
            for (int i = 0; i < NDV; ++i)
#pragma unroll
                for (int r = 0; r < 16; ++r) acc[i][r] *= alpha;
            bf16x8 pf[2][2];
#pragma unroll
            for (int t = 0; t < 2; ++t) {
                u32x4 w0, w1;
                w0.x = cvt_pk_bf16(s0[8 * t + 0], s0[8 * t + 1]); w0.y = cvt_pk_bf16(s0[8 * t + 2], s0[8 * t + 3]); w0.z = cvt_pk_bf16(s0[8 * t + 4], s0[8 * t + 5]); w0.w = cvt_pk_bf16(s0[8 * t + 6], s0[8 * t + 7]);
                w1.x = cvt_pk_bf16(s1[8 * t + 0], s1[8 * t + 1]); w1.y = cvt_pk_bf16(s1[8 * t + 2], s1[8 * t + 3]); w1.z = cvt_pk_bf16(s1[8 * t + 4], s1[8 * t + 5]); w1.w = cvt_pk_bf16(s1[8 * t + 6], s1[8 * t + 7]);
                pf[0][t] = __builtin_bit_cast(bf16x8, w0); pf[1][t] = __builtin_bit_cast(bf16x8, w1);
            }
#define AT_LOADV(dst, dvb_) do { const LAS unsigned char* vrow_ = vb + (dvoff + 32 * (dvb_) + r32) * AT_VROW + 8 * hi; \
                _Pragma("unroll") for (int i_ = 0; i_ < 4; ++i_) { const s16x4 lo4_ = *(const LAS s16x4*)(vrow_ + (16 * i_) * 2), hi4_ = *(const LAS s16x4*)(vrow_ + (16 * i_ + 8) * 2); \
                    dst[i_] = (bf16x8){lo4_[0], lo4_[1], lo4_[2], lo4_[3], hi4_[0], hi4_[1], hi4_[2], hi4_[3]}; } } while (0)
            {
                bf16x8 vcur[4], vnxt[4];
                AT_LOADV(vcur, 0);
#pragma unroll
                for (int dvb = 0; dvb < NDV; ++dvb) {
                    if (dvb + 1 < NDV) AT_LOADV(vnxt, dvb + 1);
                    __builtin_amdgcn_sched_barrier(0);
#pragma unroll
                    for (int i = 0; i < 4; ++i) acc[dvb] = __builtin_amdgcn_mfma_f32_32x32x16_bf16(vcur[i], pf[i >> 1][i & 1], acc[dvb], 0, 0, 0);
                    __builtin_amdgcn_sched_barrier(0);
#pragma unroll
                    for (int i = 0; i < 4; ++i) vcur[i] = vnxt[i];
                }
            }
#undef AT_LOADV
        }
        if (more) {
            LAS unsigned char* kb = lds + (bufsel ^ 1) * AT_BUF; LAS unsigned char* vb = kb + AT_KBYTES;
            *(LAS u32x4*)(kb + kp_row0 * AT_KROW + kp_c * 16) = kr0; *(LAS u32x4*)(kb + (kp_row0 + 32) * AT_KROW + kp_c * 16) = kr1;
            { LAS unsigned char* p0 = vb + vp_row0 * AT_VROW + vp_c * 16; LAS unsigned char* p1 = vb + (vp_row0 + 64) * AT_VROW + vp_c * 16;
          *(LAS u32x2*)p0 = (u32x2){vr0.x, vr0.y}; *(LAS u32x2*)(p0 + 8) = (u32x2){vr0.z, vr0.w}; *(LAS u32x2*)p1 = (u32x2){vr1.x, vr1.y}; *(LAS u32x2*)(p1 + 8) = (u32x2){vr1.z, vr1.w}; }
        }
    }
    const float ltot = sum_x32(lsum);
    const float inv = 1.0f / ltot;
    if (MODE == 0) {
        LAS float* xch = (LAS float*)lds;
        f32x4 sgv[NDV][4];
        if (mp == 0) {
#pragma unroll
            for (int dvb = 0; dvb < NDV; ++dvb)
#pragma unroll
                for (int g4 = 0; g4 < 4; ++g4) sgv[dvb][g4] = *(const f32x4*)(subgain + 32 * dvb + 8 * g4 + 4 * hi);
        }
        __syncthreads();
        if (mp == 1) {
#pragma unroll
            for (int dvb = 0; dvb < NDV; ++dvb)
#pragma unroll
                for (int r = 0; r < 16; ++r) { const int dv = 32 * dvb + (r & 3) + 8 * (r >> 2) + 4 * hi; xch[(wq * 128 + dv) * 32 + r32] = acc[dvb][r] * inv; }
        }
        __syncthreads();
        if (mp == 0) {
            float ss = 0.f;
#pragma unroll
            for (int dvb = 0; dvb < NDV; ++dvb)
#pragma unroll
                for (int r = 0; r < 16; ++r) { const int dv = 32 * dvb + (r & 3) + 8 * (r >> 2) + 4 * hi; const float o = acc[dvb][r] * inv - lam * xch[(wq * 128 + dv) * 32 + r32]; acc[dvb][r] = o; ss += o * o; }
            ss += shx(ss, 32, lane);
            const float rs = rsqrtf(ss * (1.0f / 128.0f) + RMS_EPS) * one_m_li;
            bf16* orow = AO + qtok * 1024 + hp * 128;
#pragma unroll
            for (int dvb = 0; dvb < NDV; ++dvb)
#pragma unroll
                for (int g4 = 0; g4 < 4; ++g4) { const int dv0 = 32 * dvb + 8 * g4 + 4 * hi; const f32x4 sg = sgv[dvb][g4];
                    u32x2 w; w.x = cvt_pk_bf16(acc[dvb][4 * g4 + 0] * rs * sg[0], acc[dvb][4 * g4 + 1] * rs * sg[1]); w.y = cvt_pk_bf16(acc[dvb][4 * g4 + 2] * rs * sg[2], acc[dvb][4 * g4 + 3] * rs * sg[3]);
                    *(u32x2*)(orow + dv0) = w; }
        }
        __syncthreads();
    } else {
        const int head = 2 * hp + mp;
        const float lse2 = mrun + __log2f(ltot);
        float wa = 0.f, wg = 1.f, lsen = lse2;
        if (gidx > 0) {
            const float la = la_pre; const float mxl = fmaxf(la, lse2);
            const float ea = fast_exp2(la - mxl), eg = fast_exp2(lse2 - mxl), tot = ea + eg;
            wa = ea / tot; wg = eg / tot; lsen = mxl + __log2f(tot);
        }
        const float sc = inv * wg;
        bf16* orow = AO + qtok * 1024 + head * 64;
#pragma unroll
        for (int dvb = 0; dvb < NDV; ++dvb)
#pragma unroll
            for (int g4 = 0; g4 < 4; ++g4) { const int dv0 = 32 * dvb + 8 * g4 + 4 * hi;
                float o0 = acc[dvb][4 * g4 + 0] * sc, o1 = acc[dvb][4 * g4 + 1] * sc, o2 = acc[dvb][4 * g4 + 2] * sc, o3 = acc[dvb][4 * g4 + 3] * sc;
                if (gidx > 0) { const u32x2 pw = pw_pre[dvb][g4]; o0 += wa * bflo(pw.x); o1 += wa * bfhi(pw.x); o2 += wa * bflo(pw.y); o3 += wa * bfhi(pw.y); }
                u32x2 w; w.x = cvt_pk_bf16(o0, o1); w.y = cvt_pk_bf16(o2, o3);
                *(u32x2*)(orow + dv0) = w; }
        if (hi == 0 && gidx < 2) LSE[qtok * 16 + head] = lsen;
        __syncthreads();
    }
}

#define XB_TMO      128
#define XB_XCNT(j)  (256  + 64 * (j))
#define XB_XSUB(j)  (1280 + 64 * (j))
#define XB_XGEN(j)  (2304 + 64 * (j))
#define XB_TOP      3328
#define XB_TOPGEN   3392
#define XCD_BAR_WORDS 3456
#define XB_SPIN_CAP (1u << 18)

__device__ __forceinline__ unsigned xb_ld(unsigned* p)              { return __hip_atomic_load(p, __ATOMIC_RELAXED, __HIP_MEMORY_SCOPE_AGENT); }
__device__ __forceinline__ unsigned xb_add(unsigned* p, unsigned v) { return __hip_atomic_fetch_add(p, v, __ATOMIC_RELAXED, __HIP_MEMORY_SCOPE_AGENT); }
__device__ __forceinline__ unsigned xb_xcc_id() { return (unsigned)__builtin_amdgcn_s_getreg((3 << 11) | 20) & 0xFu; }
#define XB_SPIN(cond, bar) do { unsigned _sp = 0; while (cond) { __builtin_amdgcn_s_sleep(1); \
    if ((++_sp & 255u) == 0u) { if (xb_ld(&(bar)[XB_TMO])) break; if (_sp > XB_SPIN_CAP) { atomicAdd(&(bar)[XB_TMO], 1u); break; } } } } while (0)

struct XcdBarrier {
    unsigned* bar; unsigned x;
    volatile LAS unsigned* st;
};

__device__ __forceinline__ XcdBarrier xcd_barrier_post(unsigned* bar, volatile LAS unsigned* st) {
    XcdBarrier b; b.bar = bar; b.x = xb_xcc_id(); b.st = st;
    if (threadIdx.x == 0) (void)xb_add(&bar[XB_XCNT(b.x)], 1u);
    return b;
}
__device__ __forceinline__ void xcd_barrier_complete(unsigned* bar, unsigned x, unsigned& nloc, unsigned& nx) {
    const unsigned G = gridDim.x * gridDim.y * gridDim.z;
    unsigned sum, cnt, mine, sp = 0u;
    for (;;) {
        sum = 0u; cnt = 0u; mine = 0u;
#pragma unroll
        for (unsigned j = 0; j < 16; ++j) { const unsigned c = xb_ld(&bar[XB_XCNT(j)]); sum += c; cnt += (c > 0u) ? 1u : 0u; mine = (j == x) ? c : mine; }
        if (sum == G) break;
        __builtin_amdgcn_s_sleep(1);
        if ((++sp & 255u) == 0u) { if (xb_ld(&bar[XB_TMO])) break; if (sp > XB_SPIN_CAP) { atomicAdd(&bar[XB_TMO], 1u); break; } }
    }
    nloc = mine > 0u ? mine : 1u; nx = cnt > 0u ? cnt : 1u;
}

__device__ __forceinline__ void xcd_barrier(const XcdBarrier& b) {
    asm volatile("s_waitcnt vmcnt(0)" ::: "memory");
    __syncthreads();
    if (threadIdx.x == 0) {
        unsigned* bar = b.bar;
        __builtin_amdgcn_s_waitcnt(0);
        unsigned nloc = b.st[0], nx = b.st[1];
        if (nloc == 0u) { xcd_barrier_complete(bar, b.x, nloc, nx); b.st[0] = nloc; b.st[1] = nx; }
        const unsigned old = xb_add(&bar[XB_XSUB(b.x)], 1u);
        const unsigned gen = old / nloc;
        if (old + 1u == (gen + 1u) * nloc) {
            __builtin_amdgcn_fence(__ATOMIC_RELEASE, "agent");
            asm volatile("s_waitcnt vmcnt(0)" ::: "memory");
            const unsigned og = xb_add(&bar[XB_TOP], 1u);
            const unsigned tg = og / nx;
            if (og + 1u == (tg + 1u) * nx) xb_add(&bar[XB_TOPGEN], 1u);
            else XB_SPIN(xb_ld(&bar[XB_TOPGEN]) == tg, bar);
            __builtin_amdgcn_fence(__ATOMIC_ACQUIRE, "agent");
            xb_add(&bar[XB_XGEN(b.x)], 1u);
            asm volatile("s_waitcnt vmcnt(0)" ::: "memory");
        } else {
            XB_SPIN(xb_ld(&bar[XB_XGEN(b.x)]) == gen, bar);
            __builtin_amdgcn_fence(__ATOMIC_ACQUIRE, "agent");
            asm volatile("s_waitcnt vmcnt(0)" ::: "memory");
        }
    }
    __syncthreads();
}

struct Args { const float* in[31]; float* out; unsigned char* ws; };


__device__ __forceinline__ void transpose_item(const float* W, int ldw, int K, int nblk, bf16* WT, int mode, int row_off, LAS float* scr, int item, int lane) {
    const int kb = item / nblk, nb = item - kb * nblk, k0 = 64 * kb, n0 = 32 * nb;
#pragma unroll 8
    for (int i = 0; i < 32; ++i) { const int kk = 2 * i + (lane >> 5); scr[kk * 33 + (lane & 31)] = W[(size_t)(k0 + kk) * ldw + n0 + (lane & 31)]; }
    asm volatile("s_waitcnt lgkmcnt(0)" ::: "memory");
    int drow;
    if (mode == 0) drow = n0;
    else if (mode == 1) { const int tile = n0 >> 8, ac = n0 & 255, wc = ac >> 6, bj = (ac >> 5) & 1; drow = 256 * tile + 128 * bj + 32 * wc; }
    else drow = 256 * (n0 >> 7) + (n0 & 127);
    drow += row_off;
    const int c = lane & 7;
#pragma unroll
    for (int j = 0; j < 4; ++j) { const int n = (lane >> 3) + 8 * j; const LAS float* s = scr + (8 * c) * 33 + n;
        u32x4 o; o.x = cvt_pk_bf16(s[0 * 33], s[1 * 33]); o.y = cvt_pk_bf16(s[2 * 33], s[3 * 33]); o.z = cvt_pk_bf16(s[4 * 33], s[5 * 33]); o.w = cvt_pk_bf16(s[6 * 33], s[7 * 33]);
        *(u32x4*)(WT + (size_t)(drow + n) * K + k0 + 8 * c) = o; }
    asm volatile("s_waitcnt lgkmcnt(0)" ::: "memory");
}

__device__ __forceinline__ int t5_bucket(int n) {
    if (n < 16) return n;
    const float nf = (float)n;
    int v = 16 + (int)(logf(nf / 16.0f) / 4.852030263919617f * 16.0f);
    return v < 31 ? v : 31;
}

__device__ __forceinline__ void norm_phase(const float* x, const float* gain, const float* shift, const float* scale, bf16* H, int bid, int ngw) {
    const int tid = opaque_tid(), lane = tid & 63, gw = bid * 8 + __builtin_amdgcn_readfirstlane(tid >> 6);
    f32x4 gv[4];
#pragma unroll
    for (int j = 0; j < 4; ++j) gv[j] = *(const f32x4*)(gain + 4 * lane + 256 * j);
    for (int row = gw; row < TOK; row += ngw) {
        const f32x4* xr = (const f32x4*)(x + (size_t)row * 1024) + lane;
        const int b = row >> 11;
        f32x4 v[4]; float s = 0.f;
#pragma unroll
        for (int j = 0; j < 4; ++j) { v[j] = xr[64 * j]; s += (v[j].x * v[j].x + v[j].y * v[j].y) + (v[j].z * v[j].z + v[j].w * v[j].w); }
        const float rstd = rsqrtf(wave_sum(s, lane) * (1.0f / 1024.0f) + RMS_EPS);
        unsigned long long* o8 = (unsigned long long*)(H + (size_t)row * 1024) + lane;
#pragma unroll
        for (int j = 0; j < 4; ++j) {
            const f32x4 sc = *(const f32x4*)(scale + (size_t)b * 6144 + 4 * lane + 256 * j), sh = *(const f32x4*)(shift + (size_t)b * 6144 + 4 * lane + 256 * j);
            const f32x4 y = v[j] * rstd * gv[j] * (sc + 1.0f) + sh;
            o8[64 * j] = (unsigned long long)cvt_pk_bf16(y.x, y.y) | ((unsigned long long)cvt_pk_bf16(y.z, y.w) << 32);
        }
    }
}

__device__ __forceinline__ void lru_coef(const u32x4 xw, const u32x4 aw, const u32x4 uw, const float (&sp)[8], const float (&bxv)[8], const float (&bav)[8], float (&l8)[8], float (&b8)[8]) {
    const float gx[8] = {bflo(xw.x), bfhi(xw.x), bflo(xw.y), bfhi(xw.y), bflo(xw.z), bfhi(xw.z), bflo(xw.w), bfhi(xw.w)};
    const float ga[8] = {bflo(aw.x), bfhi(aw.x), bflo(aw.y), bfhi(aw.y), bflo(aw.z), bfhi(aw.z), bflo(aw.w), bfhi(aw.w)};
    const float uu[8] = {bflo(uw.x), bfhi(uw.x), bflo(uw.y), bfhi(uw.y), bflo(uw.z), bfhi(uw.z), bflo(uw.w), bfhi(uw.w)};
#pragma unroll
    for (int j = 0; j < 8; ++j) {
        const float sx = __builtin_amdgcn_rcpf(1.0f + __builtin_amdgcn_exp2f(-(gx[j] + bxv[j]) * LOG2E));
        const float sa = __builtin_amdgcn_rcpf(1.0f + __builtin_amdgcn_exp2f(-(ga[j] + bav[j]) * LOG2E));
        const float la = sa * sp[j];
        const float x2 = 2.0f * la;
        const float om = (x2 > -0.02f) ? -x2 * (1.0f + x2 * (0.5f + x2 * 0.16666667f)) : 1.0f - __builtin_amdgcn_exp2f(x2 * LOG2E);
        l8[j] = la * LOG2E; b8[j] = __builtin_amdgcn_sqrtf(fmaxf(om, 0.f)) * sx * uu[j];
    }
}

__device__ __forceinline__ void norm_row_b(const bf16* xrow, bf16* hrow, const f32x4 (&gv)[2][2], const f32x4 (&scv)[2][2], const f32x4 (&shv)[2][2], int lane) {
    f32x4 v[2][2]; float s = 0.f;
#pragma unroll
    for (int j = 0; j < 2; ++j) { const u32x4 w = *(const u32x4*)(xrow + 8 * lane + 512 * j);
        v[j][0] = (f32x4){bflo(w.x), bfhi(w.x), bflo(w.y), bfhi(w.y)}; v[j][1] = (f32x4){bflo(w.z), bfhi(w.z), bflo(w.w), bfhi(w.w)};
#pragma unroll
        for (int n = 0; n < 2; ++n) s += (v[j][n].x * v[j][n].x + v[j][n].y * v[j][n].y) + (v[j][n].z * v[j][n].z + v[j][n].w * v[j][n].w); }
    const float rstd = rsqrtf(wave_sum(s, lane) * (1.0f / 1024.0f) + RMS_EPS);
#pragma unroll
    for (int j = 0; j < 2; ++j) { const f32x4 y0 = v[j][0] * rstd * gv[j][0] * scv[j][0] + shv[j][0], y1 = v[j][1] * rstd * gv[j][1] * scv[j][1] + shv[j][1];
        u32x4 w; w.x = cvt_pk_bf16(y0.x, y0.y); w.y = cvt_pk_bf16(y0.z, y0.w); w.z = cvt_pk_bf16(y1.x, y1.y); w.w = cvt_pk_bf16(y1.z, y1.w);
        *(u32x4*)(hrow + 8 * lane + 512 * j) = w; }
}
template <int R>
__device__ __forceinline__ void norm_rows_b(const bf16* xrow, bf16* hrow, const f32x4 (&gv)[2][2], const f32x4 (&scv)[2][2], const f32x4 (&shv)[2][2], int lane) {
    u32x4 w[R][2];
#pragma unroll
    for (int q = 0; q < R; ++q)
#pragma unroll
        for (int j = 0; j < 2; ++j) w[q][j] = *(const u32x4*)(xrow + (size_t)q * 1024 + 8 * lane + 512 * j);
    f32x4 v[R][2][2]; float ssq[R];
#pragma unroll
    for (int q = 0; q < R; ++q) { float s_ = 0.f;
#pragma unroll
        for (int j = 0; j < 2; ++j) { const u32x4 ww = w[q][j];
            v[q][j][0] = (f32x4){bflo(ww.x), bfhi(ww.x), bflo(ww.y), bfhi(ww.y)}; v[q][j][1] = (f32x4){bflo(ww.z), bfhi(ww.z), bflo(ww.w), bfhi(ww.w)};
#pragma unroll
            for (int n = 0; n < 2; ++n) s_ += (v[q][j][n].x * v[q][j][n].x + v[q][j][n].y * v[q][j][n].y) + (v[q][j][n].z * v[q][j][n].z + v[q][j][n].w * v[q][j][n].w); }
        ssq[q] = s_; }
#pragma unroll
    for (int o = 1; o < 64; o <<= 1)
#pragma unroll
        for (int q = 0; q < R; ++q) ssq[q] += shx(ssq[q], o, lane);
#pragma unroll
    for (int q = 0; q < R; ++q) { const float rstd = rsqrtf(ssq[q] * (1.0f / 1024.0f) + RMS_EPS);
#pragma unroll
        for (int j = 0; j < 2; ++j) { const f32x4 y0 = v[q][j][0] * rstd * gv[j][0] * scv[j][0] + shv[j][0], y1 = v[q][j][1] * rstd * gv[j][1] * scv[j][1] + shv[j][1];
            u32x4 o_; o_.x = cvt_pk_bf16(y0.x, y0.y); o_.y = cvt_pk_bf16(y0.z, y0.w); o_.z = cvt_pk_bf16(y1.x, y1.y); o_.w = cvt_pk_bf16(y1.z, y1.w);
            *(u32x4*)(hrow + (size_t)q * 1024 + 8 * lane + 512 * j) = o_; } }
}
#define NORM_B_LOAD_GAIN(gain) f32x4 gv[2][2]; _Pragma("unroll") for (int j = 0; j < 2; ++j) _Pragma("unroll") for (int n = 0; n < 2; ++n) gv[j][n] = *(const f32x4*)((gain) + 8 * lane + 512 * j + 4 * n);
#define NORM_B_LOAD_MOD(b) f32x4 scv[2][2], shv[2][2]; _Pragma("unroll") for (int j = 0; j < 2; ++j) _Pragma("unroll") for (int n = 0; n < 2; ++n) { \
        scv[j][n] = *(const f32x4*)(scale + (size_t)(b) * 6144 + 8 * lane + 512 * j + 4 * n) + 1.0f; shv[j][n] = *(const f32x4*)(shift + (size_t)(b) * 6144 + 8 * lane + 512 * j + 4 * n); }
__device__ __forceinline__ void norm_phase_b(const bf16* xb, const float* gain, const float* shift, const float* scale, bf16* H, int bid, int ngw) {
    const int tid = opaque_tid(), lane = tid & 63, gw = bid * 8 + __builtin_amdgcn_readfirstlane(tid >> 6);
    NORM_B_LOAD_GAIN(gain)
    for (int slab = gw; slab < TOK / 32; slab += ngw) {
        const int row0 = slab * 32;
        NORM_B_LOAD_MOD(row0 >> 11)
        for (int r = 0; r < 32; r += 4) norm_rows_b<4>(xb + (size_t)(row0 + r) * 1024, H + (size_t)(row0 + r) * 1024, gv, scv, shv, lane);
    }
}

__device__ __forceinline__ void norm_panels(const bf16* xb, const float* gain, const float* shift, const float* scale, bf16* H, int bid, int G) {
    const int tid = opaque_tid(), lane = tid & 63, wave = __builtin_amdgcn_readfirstlane(tid >> 6);
    NORM_B_LOAD_GAIN(gain)
    for (int pm = bid; pm < 256; pm += G) {
        NORM_B_LOAD_MOD(pm >> 3)
        const int row0 = pm * 256 + wave * 32;
        for (int r = 0; r < 32; r += 4) norm_rows_b<4>(xb + (size_t)(row0 + r) * 1024, H + (size_t)(row0 + r) * 1024, gv, scv, shv, lane);
    }
}

__global__ void __launch_bounds__(NT_, 2) fwd_mega(Args args) {
    extern __shared__ __attribute__((aligned(16))) unsigned char lds_raw[];
    LAS unsigned char* lds = (LAS unsigned char*)lds_raw;
    cg::grid_group grid = cg::this_grid();
#define GSYNC_HIP() do { asm volatile("s_waitcnt vmcnt(0) lgkmcnt(0)" ::: "memory"); grid.sync(); } while (0)
#define GSYNC() do { XcdBarrier xb_; xb_.bar = (unsigned*)(ws + WS_BAR); xb_.x = xb_xcc_id(); xb_.st = (volatile LAS unsigned*)(lds + LDS_XB_OFF); xcd_barrier(xb_); } while (0)
    const int G = gridDim.x, bid = blockIdx.x;
    if (threadIdx.x < 4) ((LAS unsigned*)(lds + LDS_XB_OFF))[threadIdx.x] = 0u;
    __syncthreads();
    (void)xcd_barrier_post((unsigned*)(args.ws + WS_BAR), (volatile LAS unsigned*)(lds + LDS_XB_OFF));
    const int ngw = G * 8, ngt = G * NT_;
#define PHASE_IDS const int tid = opaque_tid(), lane = tid & 63, wave = __builtin_amdgcn_readfirstlane(tid >> 6), gw = bid * 8 + wave, gtid = bid * NT_ + tid; (void)lane; (void)wave; (void)gw; (void)gtid;
    unsigned char* ws = args.ws;
    const float* x_in = args.in[0]; float* xo = args.out;
#define scal ((float*)(ws + WS_SCAL))
#define mod ((float*)(ws + WS_MOD))
#define biasT ((float*)(ws + WS_BIAS))
#define CS ((float*)(ws + WS_CS))
#define CH ((float*)(ws + WS_CH))
#define Hb ((bf16*)(ws + WS_H))
#define HID ((bf16*)(ws + WS_BIG))
#define QKb ((bf16*)(ws + WS_QK))
#define VTb ((bf16*)(ws + WS_VT))
#define AOb ((bf16*)(ws + WS_AO))
#define GYb ((bf16*)(ws + WS_GY))
#define Ub ((bf16*)(ws + WS_U))
#define UCb ((bf16*)(ws + WS_UC))
#define LAb ((bf16*)(ws + WS_LA))
#define BVb ((bf16*)(ws + WS_BV))
#define LSEb ((float*)(ws + WS_LSE))
#define XBb ((bf16*)(ws + WS_XB))

    {
        PHASE_IDS
        LAS float* scr = (LAS float*)(lds + wave * 8448);
        constexpr int I_W1 = 16 * 128, I_W2 = 64 * 32, I_QK = 16 * 64, I_SQ = 16 * 32, I_G = 4 * 8;
        constexpr int NITEMS = 4 * (I_W1 + I_W2) + 2 * (I_QK + 2 * I_SQ) + (I_QK + 8 * I_G + I_SQ) + (3 * (I_QK + I_SQ) + I_SQ);
#ifndef SK_TR
        for (int it = gw; it < NITEMS; it += ngw) {
            int r = it;
            if (r < 4 * I_W1) { const int l = r / I_W1; transpose_item(args.in[7] + (size_t)l * 1024 * 4096, 4096, 1024, 128, (bf16*)(ws + W_W1) + (size_t)l * 4096 * 1024, 0, 0, scr, r % I_W1, lane); continue; } r -= 4 * I_W1;
            if (r < 4 * I_W2) { const int l = r / I_W2; transpose_item(args.in[8] + (size_t)l * 4096 * 1024, 1024, 4096, 32, (bf16*)(ws + W_W2) + (size_t)l * 1024 * 4096, 0, 0, scr, r % I_W2, lane); continue; } r -= 4 * I_W2;
            if (r < 2 * I_QK) { const int s = r / I_QK; transpose_item(args.in[9] + (size_t)s * 1024 * 3072, 3072, 1024, 64, (bf16*)(ws + W_DAQK) + (size_t)s * 2048 * 1024, 1, 0, scr, r % I_QK, lane); continue; } r -= 2 * I_QK;
            if (r < 2 * I_SQ) { const int s = r / I_SQ; transpose_item(args.in[9] + (size_t)s * 1024 * 3072 + 2048, 3072, 1024, 32, (bf16*)(ws + W_DAV) + (size_t)s * 1024 * 1024, 0, 0, scr, r % I_SQ, lane); continue; } r -= 2 * I_SQ;
            if (r < 2 * I_SQ) { const int s = r / I_SQ; transpose_item(args.in[10] + (size_t)s * 1024 * 1024, 1024, 1024, 32, (bf16*)(ws + W_DAO) + (size_t)s * 1024 * 1024, 0, 0, scr, r % I_SQ, lane); continue; } r -= 2 * I_SQ;
            if (r < I_QK) { transpose_item(args.in[18], 2048, 1024, 64, (bf16*)(ws + W_LIN), 0, 0, scr, r, lane); continue; } r -= I_QK;
            if (r < 8 * I_G) { const int sm = r / I_G, blk = sm >> 1, gate = sm & 1;
                transpose_item(args.in[gate ? 23 : 21] + (size_t)blk * 65536, 256, 256, 8, (bf16*)(ws + W_LG), 2, 512 * blk + 128 * gate, scr, r % I_G, lane); continue; } r -= 8 * I_G;
            if (r < I_SQ) { transpose_item(args.in[26], 1024, 1024, 32, (bf16*)(ws + W_LOUT), 0, 0, scr, r, lane); continue; } r -= I_SQ;
            if (r < 3 * I_QK) { const int g = r / I_QK; transpose_item(args.in[27] + (size_t)g * 3072, 9216, 1024, 64, (bf16*)(ws + W_DLQK) + (size_t)g * 2048 * 1024, 1, 0, scr, r % I_QK, lane); continue; } r -= 3 * I_QK;
            if (r < 3 * I_SQ) { const int g = r / I_SQ; transpose_item(args.in[27] + (size_t)g * 3072 + 2048, 9216, 1024, 32, (bf16*)(ws + W_DLV) + (size_t)g * 1024 * 1024, 0, 0, scr, r % I_SQ, lane); continue; } r -= 3 * I_SQ;
            transpose_item(args.in[28], 1024, 1024, 32, (bf16*)(ws + W_DLO), 0, 0, scr, r, lane);
        }
#endif
        for (int i = gtid; i < 16 * 2048; i += ngt) { const int col = i >> 11, dist = i & 2047; biasT[i] = args.in[2][t5_bucket(dist) * 16 + col] * LOG2E; }
        if (gtid < 1024) ((float*)(ws + WS_SP))[gtid] = -8.0f * log1pf(expf(-args.in[25][gtid]));
        if (bid == 0 && wave == 0) {
            for (int s = 0; s < 2; ++s) {
                const float a = wave_sum(args.in[13][s * 64 + lane] * args.in[14][s * 64 + lane], lane);
                const float b2 = wave_sum(args.in[15][s * 64 + lane] * args.in[16][s * 64 + lane], lane);
                const int layer = 3 * s; const float li = 0.8f - 0.6f * expf(-0.3f * (float)layer);
                if (lane == 0) scal[s] = expf(a) - expf(b2) + li;
            }
        }
        __syncthreads();
#ifndef SK_ADALN
        {
            LAS float* sc = (LAS float*)lds; LAS float* red = (LAS float*)(lds + 131072);
            const float* cin = args.in[1];
            for (int i = tid; i < 32768; i += NT_) { const int b = i & 31, k = i >> 5; const float v = cin[b * 1024 + k]; sc[k * 32 + b] = v / (1.0f + __expf(-v)); }
            __syncthreads();
            for (int item = bid; item < 768; item += G) {
                const int l = item / 192, nb = item - l * 192, col = tid & 31, kg = tid >> 5;
                float a[32];
#pragma unroll
                for (int b = 0; b < 32; ++b) a[b] = 0.f;
                const float* wp = args.in[3] + ((size_t)l * 1024 + kg * 64) * 6144 + nb * 32 + col;
                for (int kk = 0; kk < 64; ++kk) {
                    const float w = wp[(size_t)kk * 6144]; const LAS float* row = sc + (kg * 64 + kk) * 32;
#pragma unroll
                    for (int b4 = 0; b4 < 8; ++b4) { const f32x4 s4 = *(const LAS f32x4*)(row + 4 * b4); a[4 * b4 + 0] += w * s4[0]; a[4 * b4 + 1] += w * s4[1]; a[4 * b4 + 2] += w * s4[2]; a[4 * b4 + 3] += w * s4[3]; }
                }
#pragma unroll
                for (int b = 0; b < 32; ++b) a[b] += shx(a[b], 32, lane);
                for (int w = 0; w < 8; ++w) {
                    if (wave == w && lane < 32) {
#pragma unroll
                        for (int b = 0; b < 32; ++b) { LAS float* p = red + b * 32 + col; *p = (w == 0 ? 0.f : *p) + a[b]; }
                    }
                    __syncthreads();
                }
                for (int i = tid; i < 1024; i += NT_) { const int b = i >> 5, cc = i & 31; mod[((size_t)l * 32 + b) * 6144 + nb * 32 + cc] = red[b * 32 + cc] + args.in[4][l * 6144 + nb * 32 + cc]; }
                __syncthreads();
            }
        }
#endif
    }
    if (args.ws == nullptr) GSYNC_HIP();
    GSYNC();

#pragma nounroll
    for (int layer = 0; layer < 4; ++layer) {
        asm volatile("" : "+s"(ws));
        const int kind = layer % 3, slot = layer / 3;
        const float* modl = mod + (size_t)layer * 32 * 6144;
        if (layer == 0) norm_phase(x_in, args.in[5], modl, modl + 1024, Hb, bid, ngw);
        else norm_phase_b(XBb, args.in[5] + layer * 1024, modl, modl + 1024, Hb, bid, ngw);
        GSYNC();
        const bf16* mixA; const bf16* mixW;
        if (kind == 1) {
#ifndef SK_L_WIN
            {
                pg8::Gemm g{Hb, (const bf16*)(ws + W_LIN), 1024, 1024, 1024, 256, 8, 1, 0}; pg8::StaticOrder S; S.init(256, 8, G, bid);
                pg8::EpiYU E{GYb, Ub}; pg8::gemm_phase<pg8::EpiYU, pg8::StaticOrder>(lds, g, S, E);
            }
#endif
            GSYNC();
#ifndef SK_L_CONV
            {
                PHASE_IDS
                const int ch = (gtid & 127) * 8;
                float cw[4][8], cb[8];
#pragma unroll
                for (int j = 0; j < 8; ++j) { cb[j] = args.in[20][ch + j];
#pragma unroll
                    for (int tap = 0; tap < 4; ++tap) cw[tap][j] = args.in[19][tap * 1024 + ch + j]; }
                for (int it = gtid; it < 131072; it += ngt) {
                    const int bc = it >> 7; const size_t t0 = (size_t)(bc >> 5) * 2048 + (size_t)(bc & 31) * 64; const bool halo = (bc & 31) != 0;
                    const u32x4 z4 = (u32x4){0u, 0u, 0u, 0u};
                    u32x4 p1 = halo ? *(const u32x4*)(Ub + (t0 - 1) * 1024 + ch) : z4, p2 = halo ? *(const u32x4*)(Ub + (t0 - 2) * 1024 + ch) : z4, p3 = halo ? *(const u32x4*)(Ub + (t0 - 3) * 1024 + ch) : z4;
#pragma unroll 4
                    for (int st = 0; st < 64; ++st) {
                        const u32x4 c0 = *(const u32x4*)(Ub + (t0 + st) * 1024 + ch);
                        float a[8];
#pragma unroll
                        for (int j = 0; j < 8; ++j) a[j] = cb[j];
#define CONV_TAP(tap, uw) do { a[0] += cw[tap][0] * bflo(uw.x); a[1] += cw[tap][1] * bfhi(uw.x); a[2] += cw[tap][2] * bflo(uw.y); a[3] += cw[tap][3] * bfhi(uw.y); \
                            a[4] += cw[tap][4] * bflo(uw.z); a[5] += cw[tap][5] * bfhi(uw.z); a[6] += cw[tap][6] * bflo(uw.w); a[7] += cw[tap][7] * bfhi(uw.w); } while (0)
                        CONV_TAP(0, c0); CONV_TAP(1, p1); CONV_TAP(2, p2); CONV_TAP(3, p3);
#undef CONV_TAP
                        u32x4 w; w.x = cvt_pk_bf16(a[0], a[1]); w.y = cvt_pk_bf16(a[2], a[3]); w.z = cvt_pk_bf16(a[4], a[5]); w.w = cvt_pk_bf16(a[6], a[7]);
                        *(u32x4*)(UCb + (t0 + st) * 1024 + ch) = w;
                        p3 = p2; p2 = p1; p1 = c0;
                    }
                }
            }
#endif
            GSYNC();
#ifndef SK_L_GATES
            {
                pg8::Gemm g{UCb, (const bf16*)(ws + W_LG), 1024, 256, 256, 256, 8, 1, 1}; pg8::StaticOrder S; S.init(256, 8, G, bid);
                pg8::EpiGates E{LAb, BVb}; pg8::gemm_phase<pg8::EpiGates, pg8::StaticOrder>(lds, g, S, E);
            }
#endif
            GSYNC();
#ifndef SK_L_SCAN
            { PHASE_IDS
            for (int it = gtid; it < 131072; it += ngt) {
                const int ch = (it & 127) * 8, bc = it >> 7; const size_t t0 = (size_t)(bc >> 5) * 2048 + (size_t)(bc & 31) * 64;
                float h[8], sl[8], sp[8], bxv[8], bav[8];
#pragma unroll
                for (int j = 0; j < 8; ++j) { h[j] = 0.f; sl[j] = 0.f; sp[j] = ((const float*)(ws + WS_SP))[ch + j]; bxv[j] = args.in[22][ch + j]; bav[j] = args.in[24][ch + j]; }
#pragma unroll 2
                for (int st = 0; st < 64; ++st) {
                    const u32x4 lw = *(const u32x4*)(LAb + (t0 + st) * 1024 + ch), bw = *(const u32x4*)(BVb + (t0 + st) * 1024 + ch), uw = *(const u32x4*)(UCb + (t0 + st) * 1024 + ch);
                    float l8[8], b8[8]; lru_coef(lw, bw, uw, sp, bxv, bav, l8, b8);
#pragma unroll
                    for (int j = 0; j < 8; ++j) { sl[j] += l8[j]; h[j] = fast_exp2(l8[j]) * h[j] + b8[j]; }
                }
                float* cs = CS + (size_t)bc * 1024 + ch; float* chp = CH + (size_t)bc * 1024 + ch;
                *(f32x4*)cs = (f32x4){sl[0], sl[1], sl[2], sl[3]}; *(f32x4*)(cs + 4) = (f32x4){sl[4], sl[5], sl[6], sl[7]};
                *(f32x4*)chp = (f32x4){h[0], h[1], h[2], h[3]}; *(f32x4*)(chp + 4) = (f32x4){h[4], h[5], h[6], h[7]};
            } }
            GSYNC();
            { PHASE_IDS
            for (int it = gtid; it < 131072; it += ngt) {
                const int ch = (it & 127) * 8, bc = it >> 7, bb = bc >> 5, chunk = bc & 31; const size_t t0 = (size_t)bb * 2048 + (size_t)chunk * 64;
                float h[8], sp[8], bxv[8], bav[8];
#pragma unroll
                for (int j = 0; j < 8; ++j) { h[j] = 0.f; sp[j] = ((const float*)(ws + WS_SP))[ch + j]; bxv[j] = args.in[22][ch + j]; bav[j] = args.in[24][ch + j]; }
                for (int cc = 0; cc < chunk; ++cc) {
                    const float* cs = CS + (size_t)(bb * 32 + cc) * 1024 + ch; const float* chp = CH + (size_t)(bb * 32 + cc) * 1024 + ch;
                    const f32x4 s0 = *(const f32x4*)cs, s1 = *(const f32x4*)(cs + 4), h0 = *(const f32x4*)chp, h1 = *(const f32x4*)(chp + 4);
#pragma unroll
                    for (int j = 0; j < 4; ++j) { h[j] = fast_exp2(s0[j]) * h[j] + h0[j]; h[4 + j] = fast_exp2(s1[j]) * h[4 + j] + h1[j]; }
                }
#pragma unroll 2
                for (int st = 0; st < 64; ++st) {
                    const u32x4 lw = *(const u32x4*)(LAb + (t0 + st) * 1024 + ch), bw = *(const u32x4*)(BVb + (t0 + st) * 1024 + ch), uw = *(const u32x4*)(UCb + (t0 + st) * 1024 + ch), gw4 = *(const u32x4*)(GYb + (t0 + st) * 1024 + ch);
                    float l8[8], b8[8]; lru_coef(lw, bw, uw, sp, bxv, bav, l8, b8);
                    const float g8[8] = {bflo(gw4.x), bfhi(gw4.x), bflo(gw4.y), bfhi(gw4.y), bflo(gw4.z), bfhi(gw4.z), bflo(gw4.w), bfhi(gw4.w)};
                    float o[8];
#pragma unroll
                    for (int j = 0; j < 8; ++j) { h[j] = fast_exp2(l8[j]) * h[j] + b8[j]; o[j] = h[j] * g8[j]; }
                    u32x4 w; w.x = cvt_pk_bf16(o[0], o[1]); w.y = cvt_pk_bf16(o[2], o[3]); w.z = cvt_pk_bf16(o[4], o[5]); w.w = cvt_pk_bf16(o[6], o[7]);
                    *(u32x4*)(Ub + (t0 + st) * 1024 + ch) = w;
                }
            } }
#endif
            GSYNC();
            mixA = Ub; mixW = (const bf16*)(ws + W_LOUT);
        } else {
            const int ngroups = (kind == 0) ? 1 : 3;
#pragma nounroll
            for (int gi = 0; gi < ngroups; ++gi) {
                const int dil = (kind == 0) ? 1 : (gi == 0 ? 1 : (gi == 1 ? 4 : 16));
                const bf16* wqk = (kind == 0) ? (const bf16*)(ws + W_DAQK) + (size_t)slot * 2048 * 1024 : (const bf16*)(ws + W_DLQK) + (size_t)gi * 2048 * 1024;
                const bf16* wv = (kind == 0) ? (const bf16*)(ws + W_DAV) + (size_t)slot * 1024 * 1024 : (const bf16*)(ws + W_DLV) + (size_t)gi * 1024 * 1024;
                const float* qg = (kind == 0) ? args.in[11] + slot * 64 : args.in[29];
                const float* kg = (kind == 0) ? args.in[12] + slot * 64 : args.in[30];
#ifndef SK_GQK
                {
                    pg8::Gemm g{Hb, wqk, 1024, 1024, 1024, 256, 8, 1, 0}; pg8::StaticOrder S; S.init(256, 8, G, bid);
                    pg8::EpiQK E{QKb, qg, kg}; pg8::gemm_phase<pg8::EpiQK, pg8::StaticOrder>(lds, g, S, E);
                }
#endif
#ifndef SK_GVT
                {
                    pg8::Gemm g{wv, Hb, 1024, dil * 1024, 1024, 4, 256, dil, 0}; pg8::StaticOrder S; S.init(4, 256, G, bid);
                    pg8::EpiBf16<0> E{VTb, (size_t)TOK}; pg8::gemm_phase<pg8::EpiBf16<0>, pg8::StaticOrder>(lds, g, S, E);
                }
#endif
                GSYNC();
                if (kind == 0) {
#ifndef SK_ATT0
                    const float lam = scal[slot]; const float li = 0.8f - 0.6f * expf(-0.3f * (float)layer);
                    int last_hp = -1;
                    if (G == 256) {
                        const int xcd = bid & 7, bslot = bid >> 3, grp = bslot >> 3, pp = bslot & 7;
                        for (int rnd = 0; rnd < 8; ++rnd) {
                            const int bh = (4 * xcd + (rnd & 3)) * 8 + 2 * grp + (rnd >> 2);
                            attn_unit<0>(lds, QKb, VTb, biasT, bh >> 3, bh & 7, 0, 1, 15 - pp, AOb, LSEb, 0, lam, args.in[17] + slot * 128, 1.0f - li, (bh & 7) != last_hp); last_hp = bh & 7;
                            attn_unit<0>(lds, QKb, VTb, biasT, bh >> 3, bh & 7, 0, 1, pp, AOb, LSEb, 0, lam, args.in[17] + slot * 128, 1.0f - li, false);
                        }
                    } else
                    for (int u = bid; u < 4096; u += G) { const int bh = u & 255, r = u >> 8;
                        attn_unit<0>(lds, QKb, VTb, biasT, bh >> 3, bh & 7, 0, 1, 15 - r, AOb, LSEb, 0, lam, args.in[17] + slot * 128, 1.0f - li, (bh & 7) != last_hp); last_hp = bh & 7; }
#endif
                } else {
#ifndef SK_ATT1
                    int last_hp = -1;
                    for (int u = bid; u < 4096; u += G) { const int bh = u & 255, r = u >> 8; const int c = r % dil, jb = r / dil;
                        attn_unit<1>(lds, QKb, VTb, biasT, bh >> 3, bh & 7, c, dil, jb, AOb, LSEb, gi, 0.f, nullptr, 0.f, (bh & 7) != last_hp); last_hp = bh & 7; }
#endif
                }
                GSYNC();
            }
            mixA = AOb; mixW = (kind == 0) ? (const bf16*)(ws + W_DAO) + (size_t)slot * 1024 * 1024 : (const bf16*)(ws + W_DLO);
        }
#ifndef SK_GRES
        {
            pg8::Gemm g{mixA, mixW, 1024, 1024, 1024, 256, 4, 1, 0}; pg8::RowOrder S; S.init(256, 4, G, bid);
            pg8::EpiResid E{(layer == 0) ? x_in : (const float*)nullptr, XBb, (float*)nullptr, XBb, modl + 2048}; pg8::gemm_phase<pg8::EpiResid, pg8::RowOrder>(lds, g, S, E);
            norm_panels(XBb, args.in[6] + layer * 1024, modl + 3072, modl + 4096, Hb, bid, G);
        }
#endif
        GSYNC();
#ifndef SK_GUP
        {
            pg8::Gemm g{Hb, (const bf16*)(ws + W_W1) + (size_t)layer * 4096 * 1024, 1024, 1024, 1024, 256, 16, 1, 0}; pg8::StaticOrder S; S.init(256, 16, G, bid);
            pg8::EpiBf16<1> E{HID, (size_t)4096}; pg8::gemm_phase<pg8::EpiBf16<1>, pg8::StaticOrder>(lds, g, S, E);
        }
#endif
        GSYNC();
#ifndef SK_GDOWN
        {
            pg8::Gemm g{HID, (const bf16*)(ws + W_W2) + (size_t)layer * 1024 * 4096, 4096, 4096, 4096, 256, 4, 1, 0}; pg8::StaticOrder S; S.init(256, 4, G, bid);
            pg8::EpiResid E{(const float*)nullptr, XBb, (layer == 3) ? xo : (float*)nullptr, XBb, modl + 5120}; pg8::gemm_phase<pg8::EpiResid, pg8::StaticOrder>(lds, g, S, E);
        }
#endif
        if (layer < 3) GSYNC();
    }
}

extern "C" void kernel_launch(void* const* d_in, const int* in_sizes, int n_in, void* d_out, int out_size, void* d_ws, size_t ws_size, hipStream_t stream) {
    static int grid_blocks = 0;
    if (grid_blocks == 0) {
        if (n_in != 31 || out_size != TOK * DM || ws_size < WS_END) { fprintf(stderr, "kernel_launch: unexpected shapes (n_in %d out %d ws %zu)\n", n_in, out_size, ws_size); grid_blocks = -1; return; }
        int dev = 0, cus = 0, per_cu = 0;
        hipGetDevice(&dev);
        hipDeviceGetAttribute(&cus, hipDeviceAttributeMultiprocessorCount, dev);
        if (hipFuncSetAttribute((const void*)fwd_mega, hipFuncAttributeMaxDynamicSharedMemorySize, LDS_BYTES) != hipSuccess) { fprintf(stderr, "kernel_launch: hipFuncSetAttribute failed\n"); }
        if (hipOccupancyMaxActiveBlocksPerMultiprocessor(&per_cu, (const void*)fwd_mega, NT_, LDS_BYTES) != hipSuccess || per_cu < 1) { fprintf(stderr, "kernel_launch: occupancy query gave %d\n", per_cu); per_cu = 1; }
        (void)hipGetLastError();
        grid_blocks = cus * per_cu;
    }
    if (grid_blocks < 0) return;
    if (hipMemsetAsync((char*)d_ws + WS_BAR, 0, 16384, stream) != hipSuccess) { fprintf(stderr, "kernel_launch: memset of the barrier words failed\n"); return; }
    Args a{};
    for (int i = 0; i < 31; ++i) a.in[i] = (const float*)d_in[i];
    a.out = (float*)d_out; a.ws = (unsigned char*)d_ws;
    void* kargs[] = {&a};
    hipError_t e = hipLaunchCooperativeKernel((const void*)fwd_mega, dim3(grid_blocks), dim3(NT_), kargs, LDS_BYTES, stream);
    if (e != hipSuccess) fprintf(stderr, "cooperative launch failed: %s (grid %d)\n", hipGetErrorString(e), grid_blocks);
}
```
